# Optimizing an MI355X kernel written in HIP

```python
import jax, jax.numpy as jnp
from jax import lax
import numpy as np

D_MODEL = 2048
BATCH = 1
SEQ = 8192
DEPTH = 1

D_FF = 5632
CONV_WIDTH = 4
RG_WIDTH = 2048
RG_BLOCKS = 8
RG_BLOCK = RG_WIDTH // RG_BLOCKS
RG_C = 8.0
M_HEADS = 8
M_HEAD_DIM = 256
M_WIDTH = M_HEADS * M_HEAD_DIM
M_CHUNK = 128
NORM_EPS = 1e-6
IN_SIZES = (RG_WIDTH, RG_WIDTH, M_WIDTH, M_WIDTH, D_MODEL, D_MODEL, M_HEADS, M_HEADS)
D_IN = 2 * RG_WIDTH + 2 * M_WIDTH + 2 * D_MODEL + 2 * M_HEADS

kernel_name = 'hybrid_rglru_mlstm_macaron'


def rms_norm(x, g):
    x32 = x.astype(jnp.float32)
    y = x32 * lax.rsqrt(jnp.mean(x32 * x32, axis=-1, keepdims=True) + NORM_EPS)
    return (y * g.astype(jnp.float32)).astype(x.dtype)


def swiglu_ffn(u, w_gate, w_up, w_down):
    return (jax.nn.silu(u @ w_gate) * (u @ w_up)) @ w_down


def causal_depthwise_conv(x, w, b):
    k, c = w.shape
    y = lax.conv_general_dilated(x, w[:, None, :].astype(x.dtype), window_strides=(1,),
                                 padding=[(k - 1, 0)], dimension_numbers=('NWC', 'WIO', 'NWC'),
                                 feature_group_count=c)
    return y + b.astype(x.dtype)


def _linear_recurrence_combine(left, right):
    a_l, b_l = left
    a_r, b_r = right
    return a_l * a_r, a_r * b_l + b_r


def rglru_branch(u_x, u_gate, conv_w, conv_b, w_a, b_a, w_x, b_x, lam):
    bsz, s, _ = u_x.shape
    xc = causal_depthwise_conv(u_x, conv_w, conv_b).astype(jnp.float32)
    xb = xc.reshape(bsz, s, RG_BLOCKS, RG_BLOCK)
    r = jax.nn.sigmoid(jnp.einsum('bsnd,nde->bsne', xb, w_a.astype(jnp.float32)) + b_a.astype(jnp.float32))
    i = jax.nn.sigmoid(jnp.einsum('bsnd,nde->bsne', xb, w_x.astype(jnp.float32)) + b_x.astype(jnp.float32))
    r = r.reshape(bsz, s, RG_WIDTH)
    i = i.reshape(bsz, s, RG_WIDTH)
    log_a = -RG_C * r * jax.nn.softplus(-lam.astype(jnp.float32))
    a = jnp.exp(log_a)
    beta = jnp.sqrt(-jnp.expm1(2.0 * log_a)) * (i * xc)
    _, h = lax.associative_scan(_linear_recurrence_combine, (a, beta), axis=1)
    return h.astype(u_x.dtype) * jax.nn.gelu(u_gate)


def mlstm_chunkwise(q, k, v, log_i, log_f):
    bsz, nh, s, d = q.shape
    nc, L = s // M_CHUNK, M_CHUNK
    q = q.reshape(bsz, nh, nc, L, d)
    k = k.reshape(bsz, nh, nc, L, d)
    v = v.reshape(bsz, nh, nc, L, d)
    log_i = log_i.reshape(bsz, nh, nc, L)
    b = jnp.cumsum(log_f.reshape(bsz, nh, nc, L), axis=-1)
    g = b[..., -1]
    a = g[..., None] - b + log_i
    m_loc = jnp.max(a, axis=-1)
    w = jnp.exp(a - m_loc[..., None])
    c_loc = jnp.einsum('bhcl,bhclk,bhclv->bhckv', w, k, v)
    n_loc = jnp.einsum('bhcl,bhclk->bhck', w, k)

    def step(carry, inp):
        c_st, n_st, m_st = carry
        g_c, m_c, c_c, n_c = inp
        m_new = jnp.maximum(g_c + m_st, m_c)
        s_old = jnp.exp(g_c + m_st - m_new)
        s_loc = jnp.exp(m_c - m_new)
        c_new = s_old[..., None, None] * c_st + s_loc[..., None, None] * c_c
        n_new = s_old[..., None] * n_st + s_loc[..., None] * n_c
        return (c_new, n_new, m_new), (c_st, n_st, m_st)

    init = (jnp.zeros((bsz, nh, d, d), jnp.float32), jnp.zeros((bsz, nh, d), jnp.float32),
            jnp.zeros((bsz, nh), jnp.float32))
    xs = (jnp.moveaxis(g, 2, 0), jnp.moveaxis(m_loc, 2, 0), jnp.moveaxis(c_loc, 2, 0), jnp.moveaxis(n_loc, 2, 0))
    _, (c_prev, n_prev, m_prev) = lax.scan(step, init, xs)
    c_prev = jnp.moveaxis(c_prev, 0, 2)
    n_prev = jnp.moveaxis(n_prev, 0, 2)
    m_prev = jnp.moveaxis(m_prev, 0, 2)

    causal = jnp.tril(jnp.ones((L, L), dtype=bool))
    log_d = b[..., :, None] - b[..., None, :] + log_i[..., None, :]
    log_d = jnp.where(causal, log_d, -jnp.inf)
    log_inter = b + m_prev[..., None]
    m_t = jnp.maximum(log_inter, jnp.max(log_d, axis=-1))
    scores = jnp.einsum('bhctd,bhcsd->bhcts', q, k) * jnp.exp(log_d - m_t[..., None])
    inter_w = jnp.exp(log_inter - m_t)
    num = (jnp.einsum('bhcts,bhcsv->bhctv', scores, v)
           + inter_w[..., None] * jnp.einsum('bhctk,bhckv->bhctv', q, c_prev))
    den = jnp.sum(scores, axis=-1) + inter_w * jnp.einsum('bhctk,bhck->bhct', q, n_prev)
    h = num / jnp.maximum(jnp.abs(den), jnp.exp(-m_t))[..., None]
    return h.reshape(bsz, nh, s, d)


def head_layer_norm(h, g):
    mu = jnp.mean(h, axis=-1, keepdims=True)
    var = jnp.mean(jnp.square(h - mu), axis=-1, keepdims=True)
    y = (h - mu) * lax.rsqrt(var + NORM_EPS)
    return y.reshape(h.shape[0], h.shape[1], -1) * g.astype(jnp.float32)


def mlstm_branch(u_x, u_o, pre_i, pre_f, conv_w, conv_b, w_q, w_k, w_v, b_i, b_f, norm_g, skip):
    bsz, s, _ = u_x.shape
    xc = jax.nn.silu(causal_depthwise_conv(u_x, conv_w, conv_b))
    xch = xc.reshape(bsz, s, M_HEADS, M_HEAD_DIM)
    uxh = u_x.reshape(bsz, s, M_HEADS, M_HEAD_DIM)
    q = jnp.einsum('bshd,hde->bhse', xch, w_q).astype(jnp.float32)
    k = jnp.einsum('bshd,hde->bhse', xch, w_k).astype(jnp.float32) * (M_HEAD_DIM ** -0.5)
    v = jnp.einsum('bshd,hde->bhse', uxh, w_v).astype(jnp.float32)
    log_i = jnp.swapaxes((pre_i + b_i).astype(jnp.float32), 1, 2)
    log_f = jnp.swapaxes(jax.nn.log_sigmoid((pre_f + b_f).astype(jnp.float32)), 1, 2)
    h = mlstm_chunkwise(q, k, v, log_i, log_f)
    h = head_layer_norm(jnp.swapaxes(h, 1, 2), norm_g)
    h = h + skip.astype(jnp.float32) * xc.astype(jnp.float32)
    return (jax.nn.sigmoid(u_o.astype(jnp.float32)) * h).astype(u_x.dtype)


def hybrid_mixer(u, w_in, rg_conv_w, rg_conv_b, rg_w_a, rg_b_a, rg_w_x, rg_b_x, rg_lambda,
                 m_conv_w, m_conv_b, m_w_q, m_w_k, m_w_v, m_b_i, m_b_f, m_norm, m_skip,
                 w_proj_rg, w_proj_m, w_out):
    proj = u @ w_in
    offsets = []
    acc = 0
    for size in IN_SIZES[:-1]:
        acc += size
        offsets.append(acc)
    rg_x, rg_gate, m_x, m_o, gate_rg, gate_m, m_i, m_f = jnp.split(proj, offsets, axis=-1)
    y_rg = rglru_branch(rg_x, rg_gate, rg_conv_w, rg_conv_b, rg_w_a, rg_b_a, rg_w_x, rg_b_x, rg_lambda)
    y_m = mlstm_branch(m_x, m_o, m_i, m_f, m_conv_w, m_conv_b, m_w_q, m_w_k, m_w_v, m_b_i, m_b_f, m_norm, m_skip)
    merged = jax.nn.sigmoid(gate_rg) * (y_rg @ w_proj_rg) + jax.nn.sigmoid(gate_m) * (y_m @ w_proj_m)
    return merged @ w_out


def setup_inputs(seed: int = 0) -> dict:
    key = jax.random.key(seed)
    ks = iter(jax.random.split(key, 40))
    f32 = jnp.float32

    def nrm(shape, scale):
        return jax.random.normal(next(ks), shape, f32) * scale

    L = DEPTH
    x = nrm((BATCH, SEQ, D_MODEL), 1.0)
    ffn1_norm = 1.0 + nrm((L, D_MODEL), 0.1)
    ffn1_w_gate = nrm((L, D_MODEL, D_FF), D_MODEL ** -0.5)
    ffn1_w_up = nrm((L, D_MODEL, D_FF), D_MODEL ** -0.5)
    ffn1_w_down = nrm((L, D_FF, D_MODEL), D_FF ** -0.5)
    mix_norm = 1.0 + nrm((L, D_MODEL), 0.1)
    w_in = nrm((L, D_MODEL, D_IN), D_MODEL ** -0.5)
    rg_conv_w = nrm((L, CONV_WIDTH, RG_WIDTH), CONV_WIDTH ** -0.5)
    rg_conv_b = nrm((L, RG_WIDTH), 0.01)
    rg_w_a = nrm((L, RG_BLOCKS, RG_BLOCK, RG_BLOCK), RG_BLOCK ** -0.5)
    rg_b_a = nrm((L, RG_BLOCKS, RG_BLOCK), 0.01)
    rg_w_x = nrm((L, RG_BLOCKS, RG_BLOCK, RG_BLOCK), RG_BLOCK ** -0.5)
    rg_b_x = nrm((L, RG_BLOCKS, RG_BLOCK), 0.01)
    a_base = jax.random.uniform(next(ks), (L, RG_WIDTH), f32, minval=0.9, maxval=0.999)
    rg_lambda = jnp.log(a_base) - jnp.log1p(-a_base)
    m_conv_w = nrm((L, CONV_WIDTH, M_WIDTH), CONV_WIDTH ** -0.5)
    m_conv_b = nrm((L, M_WIDTH), 0.01)
    m_w_q = nrm((L, M_HEADS, M_HEAD_DIM, M_HEAD_DIM), M_HEAD_DIM ** -0.5)
    m_w_k = nrm((L, M_HEADS, M_HEAD_DIM, M_HEAD_DIM), M_HEAD_DIM ** -0.5)
    m_w_v = nrm((L, M_HEADS, M_HEAD_DIM, M_HEAD_DIM), M_HEAD_DIM ** -0.5)
    m_b_i = nrm((L, M_HEADS), 0.1)
    m_b_f = jnp.linspace(3.0, 6.0, M_HEADS, dtype=f32)[None, :] + nrm((L, M_HEADS), 0.1)
    m_norm = 1.0 + nrm((L, M_WIDTH), 0.1)
    m_skip = 1.0 + nrm((L, M_WIDTH), 0.1)
    w_proj_rg = nrm((L, RG_WIDTH, D_MODEL), RG_WIDTH ** -0.5)
    w_proj_m = nrm((L, M_WIDTH, D_MODEL), M_WIDTH ** -0.5)
    w_out = nrm((L, D_MODEL, D_MODEL), D_MODEL ** -0.5)
    ffn2_norm = 1.0 + nrm((L, D_MODEL), 0.1)
    ffn2_w_gate = nrm((L, D_MODEL, D_FF), D_MODEL ** -0.5)
    ffn2_w_up = nrm((L, D_MODEL, D_FF), D_MODEL ** -0.5)
    ffn2_w_down = nrm((L, D_FF, D_MODEL), D_FF ** -0.5)
    final_norm = 1.0 + nrm((D_MODEL,), 0.1)
    return {'x': x, 'ffn1_norm': ffn1_norm, 'ffn1_w_gate': ffn1_w_gate, 'ffn1_w_up': ffn1_w_up,
            'ffn1_w_down': ffn1_w_down, 'mix_norm': mix_norm, 'w_in': w_in,
            'rg_conv_w': rg_conv_w, 'rg_conv_b': rg_conv_b, 'rg_w_a': rg_w_a, 'rg_b_a': rg_b_a,
            'rg_w_x': rg_w_x, 'rg_b_x': rg_b_x, 'rg_lambda': rg_lambda,
            'm_conv_w': m_conv_w, 'm_conv_b': m_conv_b, 'm_w_q': m_w_q, 'm_w_k': m_w_k, 'm_w_v': m_w_v,
            'm_b_i': m_b_i, 'm_b_f': m_b_f, 'm_norm': m_norm, 'm_skip': m_skip,
            'w_proj_rg': w_proj_rg, 'w_proj_m': w_proj_m, 'w_out': w_out,
            'ffn2_norm': ffn2_norm, 'ffn2_w_gate': ffn2_w_gate, 'ffn2_w_up': ffn2_w_up,
            'ffn2_w_down': ffn2_w_down, 'final_norm': final_norm}


def reference(x, ffn1_norm, ffn1_w_gate, ffn1_w_up, ffn1_w_down, mix_norm, w_in,
              rg_conv_w, rg_conv_b, rg_w_a, rg_b_a, rg_w_x, rg_b_x, rg_lambda,
              m_conv_w, m_conv_b, m_w_q, m_w_k, m_w_v, m_b_i, m_b_f, m_norm, m_skip,
              w_proj_rg, w_proj_m, w_out, ffn2_norm, ffn2_w_gate, ffn2_w_up, ffn2_w_down, final_norm):
    h = x
    for l in range(DEPTH):
        h = h + 0.5 * swiglu_ffn(rms_norm(h, ffn1_norm[l]), ffn1_w_gate[l], ffn1_w_up[l], ffn1_w_down[l])
        h = h + hybrid_mixer(rms_norm(h, mix_norm[l]), w_in[l],
                             rg_conv_w[l], rg_conv_b[l], rg_w_a[l], rg_b_a[l], rg_w_x[l], rg_b_x[l], rg_lambda[l],
                             m_conv_w[l], m_conv_b[l], m_w_q[l], m_w_k[l], m_w_v[l], m_b_i[l], m_b_f[l],
                             m_norm[l], m_skip[l], w_proj_rg[l], w_proj_m[l], w_out[l])
        h = h + 0.5 * swiglu_ffn(rms_norm(h, ffn2_norm[l]), ffn2_w_gate[l], ffn2_w_up[l], ffn2_w_down[l])
    return rms_norm(h, final_norm)
```

```cpp
#include <hip/hip_runtime.h>
#include <cstdio>
#include <cstdint>

#define LAS __attribute__((address_space(3)))
#define GAS __attribute__((address_space(1)))
typedef unsigned short bf16_t;
typedef short bf16x8 __attribute__((ext_vector_type(8)));
typedef float f32x4 __attribute__((ext_vector_type(4)));
typedef float f32x2 __attribute__((ext_vector_type(2)));
typedef unsigned u32x4 __attribute__((ext_vector_type(4)));
typedef unsigned u32x2 __attribute__((ext_vector_type(2)));

constexpr int SEQ = 8192, DM = 2048, FF = 5632, NH = 8, HD = 256, NCH = SEQ / 256;
constexpr int DIN = 12304;
constexpr float EPS = 1e-6f;
constexpr float LOG2E = 1.4426950408889634f;

constexpr size_t MiB = 1u << 20;
constexpr size_t SLOT = 32 * MiB;
#define WS_S(i) ((size_t)(i) * SLOT)
constexpr size_t WS_W1GU = 0, WS_W1D = 44 * MiB, WS_WIN = 66 * MiB;
constexpr size_t WS_XB = WS_S(4);
constexpr size_t WS_HID1 = WS_S(5);
constexpr size_t WS_PROJ = WS_S(5);
constexpr size_t WS_RGX = WS_S(5), WS_RGG = WS_S(6), WS_MX = WS_S(7), WS_MO = WS_S(8), WS_GRG = WS_S(9), WS_GM = WS_S(10);
constexpr size_t WS_XCRG = WS_S(0), WS_XCM = WS_S(1);
constexpr size_t WS_Q = WS_S(2), WS_K = WS_S(3), WS_QS = WS_S(4), WS_VT = WS_S(5), WS_KWT = WS_S(11);
constexpr size_t WS_P = WS_S(7), WS_CLOC = WS_S(12);
constexpr size_t WS_CP = WS_S(2), WS_YRG = WS_S(3);
constexpr size_t WS_W2GU = WS_S(11), WS_W2D = WS_S(11) + 44 * MiB, WS_WPRG = WS_S(11) + 66 * MiB, WS_WPM = WS_S(11) + 74 * MiB, WS_WOUT = WS_S(11) + 82 * MiB;
constexpr size_t WS_YM = WS_S(6), WS_MERGED = WS_S(0);
constexpr size_t WS_HID2 = WS_S(0);
constexpr size_t WS_TMRG = WS_S(1);
constexpr size_t WS_SMALL = WS_S(14);
constexpr size_t WS_CTL = WS_SMALL;
constexpr size_t CTL_BYTES = 64 * 1024;
constexpr size_t WS_WIF = WS_SMALL + 64 * 1024;
constexpr size_t WS_WRG = WS_SMALL + 1 * MiB;
constexpr size_t WS_WQ = WS_SMALL + 3 * MiB, WS_WK = WS_SMALL + 4 * MiB, WS_WV = WS_SMALL + 5 * MiB;
constexpr size_t WS_SSQ = WS_SMALL + 6 * MiB;
constexpr size_t WS_LOGI = WS_SSQ + 256 * 1024, WS_LOGF = WS_LOGI + 256 * 1024;
constexpr size_t WS_TWK = WS_LOGF + 256 * 1024, WS_TCOL = WS_TWK + 256 * 1024, WS_TROW = WS_TCOL + 256 * 1024, WS_TIW = WS_TROW + 256 * 1024, WS_TEMT = WS_TIW + 256 * 1024;
constexpr size_t WS_TCH = WS_TEMT + 256 * 1024;
constexpr size_t WS_AGGA = WS_TCH + 64 * 1024, WS_AGGB = WS_AGGA + 256 * 1024;
constexpr size_t WS_DENP = WS_AGGB + 256 * 1024;
constexpr size_t WS_NP = WS_DENP + 1 * MiB;
constexpr size_t WS_CARRY = WS_NP + 256 * 1024;
constexpr size_t WS_END = WS_CARRY + 256 * 1024;

#ifndef LDS_TEST
#define LDS_TEST 0
#endif
#ifndef NO_BARRIER
#define NO_BARRIER 0
#endif
#ifndef SKEL_XONLY
#define SKEL_XONLY 0
#endif
constexpr int RING_BYTES = 131072;
constexpr int LDS_AUX = 135168;
constexpr int LDS_CTL = LDS_TEST ? 16384 : 143360;
constexpr int LDS_BYTES = LDS_TEST ? 32768 : 147456;

#define LDS_WAIT() asm volatile("s_waitcnt lgkmcnt(0)" ::: "memory")
#define VM_WAIT() asm volatile("s_waitcnt vmcnt(0)" ::: "memory")

__device__ __forceinline__ unsigned f2bf(float f) { unsigned u = __builtin_bit_cast(unsigned, f); return (u + 0x7fffu + ((u >> 16) & 1u)) >> 16; }
__device__ __forceinline__ unsigned pk2(float lo, float hi) { return f2bf(lo) | (f2bf(hi) << 16); }
__device__ __forceinline__ float bf_lo(unsigned u) { return __builtin_bit_cast(float, u << 16); }
__device__ __forceinline__ float bf_hi(unsigned u) { return __builtin_bit_cast(float, u & 0xffff0000u); }
__device__ __forceinline__ unsigned cvt_pk_bf16(float lo, float hi) { unsigned r; asm volatile("v_cvt_pk_bf16_f32 %0, %1, %2" : "=v"(r) : "v"(lo), "v"(hi)); return r; }
__device__ __forceinline__ float fexp2(float x) { return __builtin_amdgcn_exp2f(x); }
__device__ __forceinline__ float frcp(float x) { return __builtin_amdgcn_rcpf(x); }
__device__ __forceinline__ float sigmoidf_(float x) { return frcp(1.0f + fexp2(-x * LOG2E)); }
__device__ __forceinline__ float wave_sum(float v) {
#pragma unroll
    for (int o = 1; o < 64; o <<= 1) v += __shfl_xor(v, o);
    return v;
}

namespace pg8 {
constexpr int BM = 256, BK = 64, HALF = 128, HTB = HALF * BK * 2, STAGE_BYTES = 8 * HTB, NXCD = 8, WGM = 8;
__host__ __device__ __forceinline__ int lds_byte(int r, int c) { const int st = (r >> 4) * 2 + (c >> 5), rr = r & 15, cc = c & 31, ob = rr * 64 + cc * 2; return st * 1024 + (ob ^ (((ob >> 9) & 1) << 5)); }
__host__ __device__ __forceinline__ void stage_rc(int b, int& R, int& C) { const int st = b / 1024, sb = b % 1024, swz = sb ^ (((sb >> 9) & 1) << 5); R = (st >> 1) * 16 + swz / 64; C = (st & 1) * 32 + (swz % 64) / 2; }
__host__ __device__ __forceinline__ int perm32(int rho) { const int n = rho >> 4, i = rho & 15; return 8 * (i >> 2) + 4 * n + (i & 3); }

struct Unit { int x, y, z; };
struct KSeg { int nt, sh; unsigned mask; long segA, segB; };
__host__ __device__ __forceinline__ KSeg kseg_plain(int K) { KSeg k; k.nt = K / BK; k.sh = 30; k.mask = 0x3fffffffu; k.segA = 0; k.segB = 0; return k; }

struct GridOrder {
    int nM, nN, nwg, G, c;
    __device__ void init(int nM_, int nN_, int G_, int c_) { nM = nM_; nN = nN_; nwg = nM * nN; G = G_; c = c_; }
    __device__ bool tile(int i, int& pm, int& pn) const {
        const long L = (long)i * G + c; if (L >= nwg) return false;
        int wgid = (int)L; { const int q = nwg / NXCD, r = nwg % NXCD, xcd = wgid % NXCD, off = wgid / NXCD; wgid = (xcd < r ? xcd * (q + 1) : r * (q + 1) + (xcd - r) * q) + off; }
        const int nig = WGM * nN, gid = wgid / nig, fm = gid * WGM, gsz = (nM - fm) < WGM ? (nM - fm) : WGM;
        pm = fm + ((wgid % nig) % gsz); pn = (wgid % nig) / gsz; return true;
    }
};

template <class Epi, class Sched, bool ALIGN_EPI = false>
__device__ __forceinline__ void gemm_phase(LAS unsigned char* lds, const unsigned lda, const unsigned ldb, const KSeg ks, const Sched& S, const Epi& E) {
    const int tid = threadIdx.x, wid = __builtin_amdgcn_readfirstlane(tid >> 6), lane = tid & 63, wr = wid >> 2, wc = wid & 3, fr = lane & 15, fq = lane >> 4;
    const int nt = ks.nt;
    unsigned voffA[2], voffB[2];
#pragma unroll
    for (int i = 0; i < 2; ++i) { int R, C; stage_rc(tid * 16 + i * 8192, R, C); const int Rb = Epi::PERM ? ((R & ~31) + perm32(R & 31)) : R;
        voffA[i] = (unsigned)R * lda + (unsigned)C * 2u; voffB[i] = (unsigned)Rb * ldb + (unsigned)C * 2u; }
    const size_t hstepA = (size_t)HALF * lda, hstepB = (size_t)HALF * ldb;
    const unsigned ldsw = (unsigned)wid * 1024u;
    const int aoff = lds_byte(wr * 64 + fr, fq * 8), boff = lds_byte(wc * 32 + fr, fq * 8);
#define PG8_KA(t) ((long)((t) >> ks.sh) * ks.segA + (long)((unsigned)(t) & ks.mask) * 128)
#define PG8_KB(t) ((long)((t) >> ks.sh) * ks.segB + (long)((unsigned)(t) & ks.mask) * 128)
#define PG8_SA(b, h) (((b) * 2 + (h)) * HTB)
#define PG8_SB(b, h) ((4 + (b) * 2 + (h)) * HTB)
#define PG8_STAGE(bufoff, gbase, voff) do { _Pragma("unroll") for (int _i = 0; _i < 2; ++_i) \
        __builtin_amdgcn_global_load_lds((const unsigned*)((const char*)(gbase) + (voff)[_i]), (LAS unsigned*)(lds + (bufoff) + ldsw + _i * 8192), 16, 0, 0); } while (0)
#define PG8_LDA(dst, b, h) do { _Pragma("unroll") for (int m = 0; m < 4; ++m) _Pragma("unroll") for (int k = 0; k < 2; ++k) dst[m][k] = *(const LAS bf16x8*)(lds + PG8_SA(b, h) + aoff + m * 2048 + k * 1024); } while (0)
#define PG8_LDB(dst, b, h) do { _Pragma("unroll") for (int n = 0; n < 2; ++n) _Pragma("unroll") for (int k = 0; k < 2; ++k) dst[n][k] = *(const LAS bf16x8*)(lds + PG8_SB(b, h) + boff + n * 2048 + k * 1024); } while (0)
#define PG8_MMA(ai, bj, At, Bt) do { __builtin_amdgcn_s_setprio(1); _Pragma("unroll") for (int m = 0; m < 4; ++m) _Pragma("unroll") for (int n = 0; n < 2; ++n) _Pragma("unroll") for (int k = 0; k < 2; ++k) \
        acc[ai][bj][m][n] = __builtin_amdgcn_mfma_f32_16x16x32_bf16(Bt[n][k], At[m][k], acc[ai][bj][m][n], 0, 0, 0); __builtin_amdgcn_s_setprio(0); } while (0)
#define PG8_WAIT_V(n) asm volatile("s_waitcnt vmcnt(" #n ")" ::: "memory")
#define PG8_WAIT_L(n) asm volatile("s_waitcnt lgkmcnt(" #n ")" ::: "memory")
#define PG8_BAR __builtin_amdgcn_s_barrier()
#define PG8_SCHED __builtin_amdgcn_sched_barrier(0)
    Unit cur, nxt; int ui = 0;
    if (!S.next(0, cur)) return;
    f32x4 acc[2][2][4][2];
#pragma unroll
    for (int a = 0; a < 2; ++a)
#pragma unroll
        for (int b = 0; b < 2; ++b)
#pragma unroll
            for (int m = 0; m < 4; ++m)
#pragma unroll
                for (int n = 0; n < 2; ++n) acc[a][b][m][n] = (f32x4){0.f, 0.f, 0.f, 0.f};
    bf16x8 At[4][2], B0[2][2], B1[2][2];
    const char* cA = S.aptr(cur); const char* cB = S.bptr(cur);
    {
        const long ka1 = PG8_KA(1), kb1 = PG8_KB(1);
        PG8_STAGE(PG8_SB(0, 0), cB, voffB); PG8_STAGE(PG8_SB(0, 1), cB + hstepB, voffB); PG8_STAGE(PG8_SA(0, 0), cA, voffA); PG8_STAGE(PG8_SA(0, 1), cA + hstepA, voffA);
        if (wr == 1) PG8_BAR;
        PG8_WAIT_V(2); PG8_BAR;
        PG8_STAGE(PG8_SB(1, 0), cB + kb1, voffB); PG8_STAGE(PG8_SA(1, 0), cA + ka1, voffA); PG8_STAGE(PG8_SB(1, 1), cB + hstepB + kb1, voffB);
        PG8_WAIT_V(6); PG8_BAR;
    }
    for (;;) {
        const bool has_next = S.next(ui + 1, nxt);
        const char* nA = has_next ? S.aptr(nxt) : cA; const char* nB = has_next ? S.bptr(nxt) : cB;
#pragma unroll 1
        for (int t = 0; t < nt; t += 2) {
            const bool last = (t == nt - 2);
            if constexpr (Epi::HOOK) { if (t == E.hook_t) E.hook(acc, cur, wr, wc, fr, fq); }
            const char* a1 = cA + PG8_KA(t + 1);
            const char* a2 = last ? nA : cA + PG8_KA(t + 2); const char* b2 = last ? nB : cB + PG8_KB(t + 2);
            const char* a3 = last ? nA + PG8_KA(1) : cA + PG8_KA(t + 3); const char* b3 = last ? nB + PG8_KB(1) : cB + PG8_KB(t + 3);
            PG8_LDB(B0, 0, 0); PG8_LDB(B1, 0, 1); PG8_SCHED; PG8_LDA(At, 0, 0); PG8_STAGE(PG8_SA(1, 1), a1 + hstepA, voffA);
            PG8_WAIT_V(8); PG8_WAIT_L(0); PG8_BAR; PG8_MMA(0, 0, At, B0); PG8_MMA(0, 1, At, B1); PG8_BAR; PG8_SCHED;
            PG8_LDA(At, 0, 1); PG8_STAGE(PG8_SB(0, 0), b2, voffB); PG8_STAGE(PG8_SB(0, 1), b2 + hstepB, voffB); PG8_STAGE(PG8_SA(0, 0), a2, voffA);
            PG8_WAIT_V(8); PG8_WAIT_L(0); PG8_BAR; PG8_MMA(1, 0, At, B0); PG8_MMA(1, 1, At, B1); PG8_BAR; PG8_SCHED;
            PG8_LDB(B0, 1, 0); PG8_LDB(B1, 1, 1); PG8_SCHED; PG8_LDA(At, 1, 0); PG8_STAGE(PG8_SA(0, 1), a2 + hstepA, voffA);
            PG8_WAIT_V(8); PG8_WAIT_L(0); PG8_BAR; PG8_MMA(0, 0, At, B0); PG8_MMA(0, 1, At, B1); PG8_BAR; PG8_SCHED;
            PG8_LDA(At, 1, 1); PG8_STAGE(PG8_SB(1, 0), b3, voffB); PG8_STAGE(PG8_SB(1, 1), b3 + hstepB, voffB); PG8_STAGE(PG8_SA(1, 0), a3, voffA);
            PG8_WAIT_V(8); PG8_WAIT_L(0); PG8_BAR; PG8_MMA(1, 0, At, B0); PG8_MMA(1, 1, At, B1); PG8_BAR; PG8_SCHED;
        }
        if constexpr (ALIGN_EPI) { if (wr == 0) PG8_BAR; }
        if constexpr (!Epi::AFTER_DRAIN) { int fr_ = fr, fq_ = fq; asm volatile("" : "+v"(fr_), "+v"(fq_)); E(acc, cur, wr, wc, fr_, fq_); }
        if (!has_next) break;
#pragma unroll
        for (int a = 0; a < 2; ++a)
#pragma unroll
            for (int b = 0; b < 2; ++b)
#pragma unroll
                for (int m = 0; m < 4; ++m)
#pragma unroll
                    for (int n = 0; n < 2; ++n) acc[a][b][m][n] = (f32x4){0.f, 0.f, 0.f, 0.f};
        cur = nxt; cA = nA; cB = nB; ++ui;
        if constexpr (ALIGN_EPI) { if (wr == 1) PG8_BAR; }
    }
    PG8_WAIT_V(0);
    if constexpr (!ALIGN_EPI) { if (wr == 0) PG8_BAR; }
    PG8_BAR;
    if constexpr (Epi::AFTER_DRAIN) { int fr_ = fr, fq_ = fq, lane_ = lane; asm volatile("" : "+v"(fr_), "+v"(fq_), "+v"(lane_)); E.fused(acc, cur, wr, wc, fr_, fq_, lds, wid, lane_); }
#undef PG8_KA
#undef PG8_KB
#undef PG8_SA
#undef PG8_SB
#undef PG8_STAGE
#undef PG8_LDA
#undef PG8_LDB
#undef PG8_MMA
#undef PG8_WAIT_V
#undef PG8_WAIT_L
#undef PG8_BAR
#undef PG8_SCHED
}
}
using pg8::Unit; using pg8::KSeg; using pg8::GridOrder;

#define XB_TMO      128
#define XB_XCNT(j)  (256  + 64 * (j))
#define XB_XSUB(j)  (1280 + 64 * (j))
#define XB_XGEN(j)  (2304 + 64 * (j))
#define XB_TOP      3328
#define XB_TOPGEN   3392
#define XCD_BAR_WORDS 3456
#define XB_SPIN_CAP (1u << 18)
__device__ __forceinline__ unsigned xb_ld(unsigned* p)              { return __hip_atomic_load(p, __ATOMIC_RELAXED, __HIP_MEMORY_SCOPE_AGENT); }
__device__ __forceinline__ unsigned xb_add(unsigned* p, unsigned v) { return __hip_atomic_fetch_add(p, v, __ATOMIC_RELAXED, __HIP_MEMORY_SCOPE_AGENT); }
__device__ __forceinline__ unsigned xb_xcc_id() { return (unsigned)__builtin_amdgcn_s_getreg((3 << 11) | 20) & 0xFu; }
#define XB_SPIN(cond, bar) do { unsigned _sp = 0; while (cond) { __builtin_amdgcn_s_sleep(1); \
    if ((++_sp & 255u) == 0u) { if (xb_ld(&(bar)[XB_TMO])) break; if (_sp > XB_SPIN_CAP) { atomicAdd(&(bar)[XB_TMO], 1u); break; } } } } while (0)
struct XcdBarrier { unsigned* bar; unsigned x; volatile LAS unsigned* st; };
__device__ __forceinline__ XcdBarrier xcd_barrier_post(unsigned* bar, volatile LAS unsigned* st) {
    XcdBarrier b; b.bar = bar; b.x = xb_xcc_id(); b.st = st;
    if (threadIdx.x == 0) (void)xb_add(&bar[XB_XCNT(b.x)], 1u);
    return b;
}
__device__ __forceinline__ void xcd_barrier_complete(unsigned* bar, unsigned x, unsigned& nloc, unsigned& nx) {
    const unsigned G = gridDim.x * gridDim.y * gridDim.z;
    unsigned sum, cnt, mine, sp = 0u;
    for (;;) {
        sum = 0u; cnt = 0u; mine = 0u;
#pragma unroll
        for (unsigned j = 0; j < 16; ++j) { const unsigned c = xb_ld(&bar[XB_XCNT(j)]); sum += c; cnt += (c > 0u) ? 1u : 0u; mine = (j == x) ? c : mine; }
        if (sum == G) break;
        __builtin_amdgcn_s_sleep(1);
        if ((++sp & 255u) == 0u) { if (xb_ld(&bar[XB_TMO])) break; if (sp > XB_SPIN_CAP) { atomicAdd(&bar[XB_TMO], 1u); break; } }
    }
    nloc = mine > 0u ? mine : 1u; nx = cnt > 0u ? cnt : 1u;
}
__device__ __forceinline__ void xcd_barrier(const XcdBarrier& b) {
    asm volatile("s_waitcnt vmcnt(0)" ::: "memory");
    __syncthreads();
    if (threadIdx.x == 0) {
        unsigned* bar = b.bar;
        __builtin_amdgcn_s_waitcnt(0);
        unsigned nloc = b.st[0], nx = b.st[1];
        if (nloc == 0u) { xcd_barrier_complete(bar, b.x, nloc, nx); b.st[0] = nloc; b.st[1] = nx; }
        const unsigned old = xb_add(&bar[XB_XSUB(b.x)], 1u);
        const unsigned gen = old / nloc;
        if (old + 1u == (gen + 1u) * nloc) {
            __builtin_amdgcn_fence(__ATOMIC_RELEASE, "agent");
            asm volatile("s_waitcnt vmcnt(0)" ::: "memory");
            const unsigned og = xb_add(&bar[XB_TOP], 1u);
            const unsigned tg = og / nx;
            if (og + 1u == (tg + 1u) * nx) xb_add(&bar[XB_TOPGEN], 1u);
            else XB_SPIN(xb_ld(&bar[XB_TOPGEN]) == tg, bar);
            __builtin_amdgcn_fence(__ATOMIC_ACQUIRE, "agent");
            xb_add(&bar[XB_XGEN(b.x)], 1u);
            asm volatile("s_waitcnt vmcnt(0)" ::: "memory");
        } else {
            XB_SPIN(xb_ld(&bar[XB_XGEN(b.x)]) == gen, bar);
            __builtin_amdgcn_fence(__ATOMIC_ACQUIRE, "agent");
            asm volatile("s_waitcnt vmcnt(0)" ::: "memory");
        }
    }
    __syncthreads();
}

struct Frame {
    LAS unsigned char* lds;
    int tid, lane, wave, vcu, G;
    unsigned char* ws;
    float* H;
};

struct TJob { const float* W; int ldw, K, N; bf16_t* WT; int ldt, row_off, rs128; const float* ksc; float mul; };
__device__ __forceinline__ void transpose_item(const TJob& j, LAS float* scr, int item, int lane) {
    const int nblk = j.N / 32, kb = item / nblk, nb = item % nblk, k0 = 64 * kb, n0 = 32 * nb;
#pragma unroll 8
    for (int i = 0; i < 32; ++i) { const int kk = 2 * i + (lane >> 5); float v = j.W[(size_t)(k0 + kk) * j.ldw + n0 + (lane & 31)];
        if (j.ksc) v *= j.ksc[k0 + kk];
        scr[kk * 33 + (lane & 31)] = v * j.mul; }
    LDS_WAIT(); asm volatile("" ::: "memory");
    const int c = lane & 7;
    const int drow0 = j.row_off + (n0 >> 7) * j.rs128 + (n0 & 127);
#pragma unroll
    for (int q = 0; q < 4; ++q) { const int n = (lane >> 3) + 8 * q; const LAS float* s = scr + (8 * c) * 33 + n;
        u32x4 o; o.x = pk2(s[0 * 33], s[1 * 33]); o.y = pk2(s[2 * 33], s[3 * 33]); o.z = pk2(s[4 * 33], s[5 * 33]); o.w = pk2(s[6 * 33], s[7 * 33]);
        *(GAS u32x4*)(j.WT + (size_t)(drow0 + n) * j.ldt + k0 + 8 * c) = o; }
    LDS_WAIT(); asm volatile("" ::: "memory");
}

struct Ptrs { const float* in[31]; };

__device__ __forceinline__ bool get_job(const Ptrs& P, unsigned char* ws, int stage, int it, TJob& j, int& item) {
    int r = it;
    if (stage == 0) {
        constexpr int I_GU = (DM / 64) * (FF / 32), I_D = (FF / 64) * (DM / 32), I_IN = (DM / 64) * (12288 / 32), I_B = (256 / 64) * (256 / 32);
        if (r < I_GU) { j = TJob{P.in[2], FF, DM, FF, (bf16_t*)(ws + WS_W1GU), DM, 0, 256, P.in[1], 1.f}; item = r; return true; } r -= I_GU;
        if (r < I_GU) { j = TJob{P.in[3], FF, DM, FF, (bf16_t*)(ws + WS_W1GU), DM, 128, 256, P.in[1], 1.f}; item = r; return true; } r -= I_GU;
        if (r < I_D) { j = TJob{P.in[4], DM, FF, DM, (bf16_t*)(ws + WS_W1D), FF, 0, 128, nullptr, 1.f}; item = r; return true; } r -= I_D;
        if (r < I_IN) { j = TJob{P.in[6], DIN, DM, 12288, (bf16_t*)(ws + WS_WIN), DM, 0, 128, P.in[5], 1.f}; item = r; return true; } r -= I_IN;
        if (r < 16 * I_B) { const int b = r / I_B, blk = b >> 1, which = b & 1; j = TJob{P.in[which ? 11 : 9] + (size_t)blk * 65536, 256, 256, 256, (bf16_t*)(ws + WS_WRG), 256, blk * 512 + which * 128, 256, nullptr, 1.f}; item = r % I_B; return true; } r -= 16 * I_B;
        if (r < 24 * I_B) { const int b = r / I_B, which = b >> 3, h = b & 7;
            j = TJob{P.in[16 + which] + (size_t)h * 65536, 256, 256, 256, (bf16_t*)(ws + (which == 0 ? WS_WQ : which == 1 ? WS_WK : WS_WV)), 256, h * 256, 128, nullptr, which == 1 ? 0.0625f : 1.f}; item = r % I_B; return true; }
        return false;
    } else {
        constexpr int I_GU = (DM / 64) * (FF / 32), I_D = (FF / 64) * (DM / 32), I_SQ = (DM / 64) * (DM / 32);
        if (r < I_GU) { j = TJob{P.in[27], FF, DM, FF, (bf16_t*)(ws + WS_W2GU), DM, 0, 256, P.in[26], 1.f}; item = r; return true; } r -= I_GU;
        if (r < I_GU) { j = TJob{P.in[28], FF, DM, FF, (bf16_t*)(ws + WS_W2GU), DM, 128, 256, P.in[26], 1.f}; item = r; return true; } r -= I_GU;
        if (r < I_D) { j = TJob{P.in[29], DM, FF, DM, (bf16_t*)(ws + WS_W2D), FF, 0, 128, nullptr, 1.f}; item = r; return true; } r -= I_D;
        if (r < I_SQ) { j = TJob{P.in[23], DM, DM, DM, (bf16_t*)(ws + WS_WPRG), DM, 0, 128, nullptr, 1.f}; item = r; return true; } r -= I_SQ;
        if (r < I_SQ) { j = TJob{P.in[24], DM, DM, DM, (bf16_t*)(ws + WS_WPM), DM, 0, 128, nullptr, 1.f}; item = r; return true; } r -= I_SQ;
        if (r < I_SQ) { j = TJob{P.in[25], DM, DM, DM, (bf16_t*)(ws + WS_WOUT), DM, 0, 128, nullptr, 1.f}; item = r; return true; }
        return false;
    }
}
__device__ __forceinline__ void convert_weights(Frame& F, const Ptrs& P, int stage) {
    LAS float* scr = (LAS float*)(F.lds + F.wave * 16384);
    const int gw = F.vcu * 8 + F.wave, NGW = F.G * 8;
    for (int it = gw;; it += NGW) { TJob j; int item; if (!get_job(P, F.ws, stage, it, j, item)) break; transpose_item(j, scr, item, F.lane); }
}

__device__ __forceinline__ void p0_rows(Frame& F, const float* x) {
    const int gw = F.vcu * 8 + F.wave, NGW = F.G * 8;
    bf16_t* XB = (bf16_t*)(F.ws + WS_XB); float* SSQ = (float*)(F.ws + WS_SSQ);
    for (int m = gw; m < SEQ; m += NGW) {
        const GAS f32x4* xr = (const GAS f32x4*)(x + (size_t)m * DM) + F.lane;
        GAS u32x2* o8 = (GAS u32x2*)(XB + (size_t)m * DM) + F.lane;
        float s = 0.f;
#pragma unroll
        for (int j = 0; j < 8; ++j) { const f32x4 v = xr[64 * j]; s += (v.x * v.x + v.y * v.y) + (v.z * v.z + v.w * v.w); u32x2 w; w.x = pk2(v.x, v.y); w.y = pk2(v.z, v.w); o8[64 * j] = w; }
        s = wave_sum(s);
        if (F.lane < 8) SSQ[(size_t)m * 8 + F.lane] = F.lane == 0 ? s : 0.f;
#if 0
        { GAS f32x4* hr = (GAS f32x4*)(F.H + (size_t)m * DM) + F.lane;
#pragma unroll
          for (int j = 0; j < 8; ++j) hr[64 * j] = xr[64 * j]; }
#endif
    }
}
__device__ __forceinline__ void p0_wif(Frame& F, const float* w_in, const float* mix_norm) {
    const int g = (int)blockIdx.x * 512 + F.tid; if (g >= 16 * DM) return;
    const int j = g >> 11, k = g & 2047;
    ((bf16_t*)(F.ws + WS_WIF))[g] = (bf16_t)f2bf(w_in[(size_t)k * DIN + 12288 + j] * mix_norm[k]);
}

__device__ __forceinline__ void final_norm(Frame& F, const float* g) {
    const int gw = F.vcu * 8 + F.wave, NGW = F.G * 8;
    for (int m = gw; m < SEQ; m += NGW) {
        GAS f32x4* xr = (GAS f32x4*)(F.H + (size_t)m * DM) + F.lane;
        f32x4 v[8]; float s = 0.f;
#pragma unroll
        for (int j = 0; j < 8; ++j) { v[j] = xr[64 * j]; s += (v[j].x * v[j].x + v[j].y * v[j].y) + (v[j].z * v[j].z + v[j].w * v[j].w); }
        const float rs = 1.0f / sqrtf(wave_sum(s) * (1.0f / DM) + EPS);
#pragma unroll
        for (int j = 0; j < 8; ++j) { const f32x4 gg = *((const GAS f32x4*)g + F.lane + 64 * j); xr[64 * j] = v[j] * rs * gg; }
    }
}

__device__ __forceinline__ float row_rs(const float* SSQ, int row) {
    const f32x4 a = *(const GAS f32x4*)(SSQ + (size_t)row * 8), b = *(const GAS f32x4*)(SSQ + (size_t)row * 8 + 4);
    const float s = ((a.x + a.y) + (a.z + a.w)) + ((b.x + b.y) + (b.z + b.w));
    return 1.0f / sqrtf(s * (1.0f / DM) + EPS);
}

struct EpiSwiglu {
    static constexpr bool PERM = true, AFTER_DRAIN = false, HOOK = false;
    bf16_t* O; const float* SSQ;
    __device__ __forceinline__ void operator()(const f32x4 (&acc)[2][2][4][2], const Unit& u, int wr, int wc, int fr, int fq) const {
        const int col0 = u.y * 128 + wc * 32 + 8 * fq;
#pragma unroll
        for (int ai = 0; ai < 2; ++ai)
#pragma unroll
            for (int m = 0; m < 4; ++m) { const int row = u.x * 256 + ai * 128 + wr * 64 + m * 16 + fr; const float rs = row_rs(SSQ, row);
                float o[8];
#pragma unroll
                for (int n = 0; n < 2; ++n)
#pragma unroll
                    for (int e = 0; e < 4; ++e) { const float g = acc[ai][0][m][n][e] * rs, up = acc[ai][1][m][n][e] * rs; o[n * 4 + e] = g * sigmoidf_(g) * up; }
                u32x4 w; w.x = cvt_pk_bf16(o[0], o[1]); w.y = cvt_pk_bf16(o[2], o[3]); w.z = cvt_pk_bf16(o[4], o[5]); w.w = cvt_pk_bf16(o[6], o[7]);
                *(GAS u32x4*)(O + (size_t)row * FF + col0) = w; }
    }
};
struct SchedGrid {
    GridOrder go; const char* A; const char* B; size_t a_tile, b_tile;
    __device__ __forceinline__ bool next(int i, Unit& u) const { int pm, pn; if (!go.tile(i, pm, pn)) return false; u.x = pm; u.y = pn; u.z = 0; return true; }
    __device__ __forceinline__ const char* aptr(const Unit& u) const { return A + (size_t)u.x * a_tile; }
    __device__ __forceinline__ const char* bptr(const Unit& u) const { return B + (size_t)u.y * b_tile; }
};

struct EpiResid {
    static constexpr bool PERM = false, AFTER_DRAIN = true, HOOK = false;
    const float* resid; float* H; bf16_t* XB; float* SSQ; float scale;
    __device__ __forceinline__ void fused(f32x4 (&acc)[2][2][4][2], const Unit& u, int wr, int wc, int fr, int fq, LAS unsigned char* lds, int wid, int lane) const {
        LAS float* Pp = (LAS float*)lds;
        const int col0 = u.y * 256 + wc * 32 + 4 * fq;
#pragma unroll
        for (int ai = 0; ai < 2; ++ai)
#pragma unroll
            for (int m = 0; m < 4; ++m) { const int rl = ai * 128 + wr * 64 + m * 16 + fr; const size_t off = (size_t)(u.x * 256 + rl) * DM + col0; float s = 0.f;
#pragma unroll
                for (int bj = 0; bj < 2; ++bj)
#pragma unroll
                    for (int n = 0; n < 2; ++n) { const size_t o2 = off + bj * 128 + n * 16; const f32x4 r = *(const GAS f32x4*)(resid + o2); const f32x4 h = r + acc[ai][bj][m][n] * scale;
                        *(GAS f32x4*)(H + o2) = h; s += (h.x * h.x + h.y * h.y) + (h.z * h.z + h.w * h.w);
                        if (XB) { u32x2 w; w.x = cvt_pk_bf16(h.x, h.y); w.y = cvt_pk_bf16(h.z, h.w); *(GAS u32x2*)(XB + o2) = w; } }
                s += __shfl_xor(s, 16); s += __shfl_xor(s, 32);
                if (fq == 0) Pp[rl * 4 + wc] = s; }
        LDS_WAIT(); __syncthreads();
        const int t = threadIdx.x;
        if (t < 256) { const f32x4 p = *(const LAS f32x4*)(Pp + t * 4); SSQ[(size_t)(u.x * 256 + t) * 8 + u.y] = (p.x + p.y) + (p.z + p.w); }
        __syncthreads();
    }
};

struct EpiProj {
    static constexpr bool PERM = true, AFTER_DRAIN = false, HOOK = false;
    bf16_t* O; const float* SSQ;
    __device__ __forceinline__ void operator()(const f32x4 (&acc)[2][2][4][2], const Unit& u, int wr, int wc, int fr, int fq) const {
        const int t = u.y >> 3, colt = (u.y & 7) * 256 + wc * 32 + 8 * fq; bf16_t* base = O + (size_t)t * ((size_t)SEQ * DM);
#pragma unroll
        for (int ai = 0; ai < 2; ++ai)
#pragma unroll
            for (int m = 0; m < 4; ++m) { const int row = u.x * 256 + ai * 128 + wr * 64 + m * 16 + fr; const float rs = row_rs(SSQ, row);
#pragma unroll
                for (int bj = 0; bj < 2; ++bj) { const f32x4 v0 = acc[ai][bj][m][0] * rs, v1 = acc[ai][bj][m][1] * rs;
                    u32x4 w; w.x = cvt_pk_bf16(v0.x, v0.y); w.y = cvt_pk_bf16(v0.z, v0.w); w.z = cvt_pk_bf16(v1.x, v1.y); w.w = cvt_pk_bf16(v1.z, v1.w);
                    *(GAS u32x4*)(base + (size_t)row * DM + colt + bj * 128) = w; } }
    }
};

__device__ __forceinline__ void thin_gates(Frame& F, const float* b_i, const float* b_f) {
    const bf16_t* XB = (const bf16_t*)(F.ws + WS_XB); const bf16_t* WIF = (const bf16_t*)(F.ws + WS_WIF); const float* SSQ = (const float*)(F.ws + WS_SSQ);
    float* LOGI = (float*)(F.ws + WS_LOGI); float* LOGF = (float*)(F.ws + WS_LOGF);
    const int r0 = 32 * (int)blockIdx.x, rg = F.wave & 1, kp = F.wave >> 1, l = F.lane;
    f32x4 acc = (f32x4){0.f, 0.f, 0.f, 0.f};
    const bf16_t* ap = XB + (size_t)(r0 + 16 * rg + (l & 15)) * DM + kp * 512 + 8 * (l >> 4);
    const bf16_t* bp = WIF + (size_t)(l & 15) * DM + kp * 512 + 8 * (l >> 4);
#pragma unroll 4
    for (int s = 0; s < 16; ++s) { const bf16x8 a = *(const GAS bf16x8*)(ap + 32 * s), b = *(const GAS bf16x8*)(bp + 32 * s); acc = __builtin_amdgcn_mfma_f32_16x16x32_bf16(a, b, acc, 0, 0, 0); }
    LAS float* part = (LAS float*)F.lds;
#pragma unroll
    for (int r = 0; r < 4; ++r) part[((kp * 2 + rg) * 16 + (l >> 4) * 4 + r) * 16 + (l & 15)] = acc[r];
    LDS_WAIT(); __syncthreads();
    { const int t = F.tid, g2 = t >> 8, row = (t >> 4) & 15, col = t & 15;
      float v = 0.f;
#pragma unroll
      for (int k = 0; k < 4; ++k) v += part[((k * 2 + g2) * 16 + row) * 16 + col];
      const int rowg = r0 + 16 * g2 + row; v *= row_rs(SSQ, rowg);
      const int h = col & 7;
      if (col < 8) LOGI[(size_t)h * SEQ + rowg] = v + b_i[h];
      else { const float x = v + b_f[h]; LOGF[(size_t)h * SEQ + rowg] = fminf(x, 0.f) - log1pf(expf(-fabsf(x))); } }
    __syncthreads();
}

__device__ __forceinline__ void conv_block(Frame& F, const Ptrs& P, int rb) {
    const int sel = F.tid >> 8, c8 = (F.tid & 255) * 8;
    const bf16_t* X = (const bf16_t*)(F.ws + (sel ? WS_MX : WS_RGX)); bf16_t* Y = (bf16_t*)(F.ws + (sel ? WS_XCM : WS_XCRG));
    const float* cw = P.in[sel ? 14 : 7]; const float* cb = P.in[sel ? 15 : 8];
    float w[4][8], b[8];
#pragma unroll
    for (int j = 0; j < 4; ++j) { const f32x4 a = *(const GAS f32x4*)(cw + j * DM + c8), bb = *(const GAS f32x4*)(cw + j * DM + c8 + 4); w[j][0] = a.x; w[j][1] = a.y; w[j][2] = a.z; w[j][3] = a.w; w[j][4] = bb.x; w[j][5] = bb.y; w[j][6] = bb.z; w[j][7] = bb.w; }
    { const f32x4 a = *(const GAS f32x4*)(cb + c8), bb = *(const GAS f32x4*)(cb + c8 + 4); b[0] = a.x; b[1] = a.y; b[2] = a.z; b[3] = a.w; b[4] = bb.x; b[5] = bb.y; b[6] = bb.z; b[7] = bb.w; }
    const int t0 = rb * 32;
    u32x4 h0, h1, h2;
    const u32x4 z = (u32x4){0u, 0u, 0u, 0u};
    h0 = t0 >= 3 ? *(const GAS u32x4*)(X + (size_t)(t0 - 3) * DM + c8) : z;
    h1 = t0 >= 2 ? *(const GAS u32x4*)(X + (size_t)(t0 - 2) * DM + c8) : z;
    h2 = t0 >= 1 ? *(const GAS u32x4*)(X + (size_t)(t0 - 1) * DM + c8) : z;
#pragma unroll 4
    for (int r = 0; r < 32; ++r) {
        const u32x4 cur = *(const GAS u32x4*)(X + (size_t)(t0 + r) * DM + c8);
        float y[8];
#pragma unroll
        for (int q = 0; q < 4; ++q) {
            y[2 * q]     = b[2 * q]     + w[0][2 * q]     * bf_lo(h0[q]) + w[1][2 * q]     * bf_lo(h1[q]) + w[2][2 * q]     * bf_lo(h2[q]) + w[3][2 * q]     * bf_lo(cur[q]);
            y[2 * q + 1] = b[2 * q + 1] + w[0][2 * q + 1] * bf_hi(h0[q]) + w[1][2 * q + 1] * bf_hi(h1[q]) + w[2][2 * q + 1] * bf_hi(h2[q]) + w[3][2 * q + 1] * bf_hi(cur[q]);
        }
        if (sel) {
#pragma unroll
            for (int q = 0; q < 8; ++q) y[q] = y[q] * sigmoidf_(y[q]);
        }
        u32x4 o; o.x = pk2(y[0], y[1]); o.y = pk2(y[2], y[3]); o.z = pk2(y[4], y[5]); o.w = pk2(y[6], y[7]);
        *(GAS u32x4*)(Y + (size_t)(t0 + r) * DM + c8) = o;
        h0 = h1; h1 = h2; h2 = cur;
    }
}

__device__ __forceinline__ float wave_max(float v) {
#pragma unroll
    for (int o = 1; o < 64; o <<= 1) v = fmaxf(v, __shfl_xor(v, o));
    return v;
}
__device__ __forceinline__ void gate_prep(Frame& F, int h, int c) {
    const float* LF = (const float*)(F.ws + WS_LOGF) + (size_t)h * SEQ; const float* LI = (const float*)(F.ws + WS_LOGI) + (size_t)h * SEQ;
    float* TWK = (float*)(F.ws + WS_TWK) + (size_t)h * SEQ; float* TCOL = (float*)(F.ws + WS_TCOL) + (size_t)h * SEQ; float* TROW = (float*)(F.ws + WS_TROW) + (size_t)h * SEQ;
    float* TIW = (float*)(F.ws + WS_TIW) + (size_t)h * SEQ; float* TEMT = (float*)(F.ws + WS_TEMT) + (size_t)h * SEQ; float* TCH = (float*)(F.ws + WS_TCH);
    const int l = F.lane;
    float m_st = 0.f;
    f32x4 lf = *(const GAS f32x4*)(LF + 4 * l), li = *(const GAS f32x4*)(LI + 4 * l);
    for (int cc = 0; cc <= c; ++cc) {
        f32x4 lfn = lf, lin = li;
        if (cc < c) { lfn = *(const GAS f32x4*)(LF + 256 * (cc + 1) + 4 * l); lin = *(const GAS f32x4*)(LI + 256 * (cc + 1) + 4 * l); }
        const float s0 = lf.x, s1 = s0 + lf.y, s2 = s1 + lf.z, s3 = s2 + lf.w;
        float incl = s3;
#pragma unroll
        for (int o = 1; o < 64; o <<= 1) { const float t = __shfl_up(incl, o); if (l >= o) incl += t; }
        const float excl = incl - s3;
        const float b0 = excl + s0, b1 = excl + s1, b2 = excl + s2, b3 = excl + s3;
        const float g = __shfl(incl, 63);
        const float a0 = g - b0 + li.x, a1 = g - b1 + li.y, a2 = g - b2 + li.z, a3 = g - b3 + li.w;
        const float m_loc = wave_max(fmaxf(fmaxf(a0, a1), fmaxf(a2, a3)));
        const float m_new = fmaxf(g + m_st, m_loc);
        if (cc == c) {
            const float c0 = li.x - b0, c1 = li.y - b1, c2 = li.z - b2, c3 = li.w - b3;
            const float p0 = c0, p1 = fmaxf(p0, c1), p2 = fmaxf(p1, c2), p3 = fmaxf(p2, c3);
            float im = p3;
#pragma unroll
            for (int o = 1; o < 64; o <<= 1) { const float t = __shfl_up(im, o); if (l >= o) im = fmaxf(im, t); }
            float ex = __shfl_up(im, 1); if (l == 0) ex = -INFINITY;
            const float q0 = fmaxf(ex, p0), q1 = fmaxf(ex, p1), q2 = fmaxf(ex, p2), q3 = fmaxf(ex, p3);
            const float mp = m_st;
            const float x0 = fmaxf(mp, q0), x1 = fmaxf(mp, q1), x2 = fmaxf(mp, q2), x3 = fmaxf(mp, q3);
            const int o4 = 256 * c + 4 * l;
            *(GAS f32x4*)(TROW + o4) = (f32x4){-x0 * LOG2E, -x1 * LOG2E, -x2 * LOG2E, -x3 * LOG2E};
            *(GAS f32x4*)(TCOL + o4) = (f32x4){c0 * LOG2E, c1 * LOG2E, c2 * LOG2E, c3 * LOG2E};
            *(GAS f32x4*)(TIW + o4) = (f32x4){expf(mp - x0), expf(mp - x1), expf(mp - x2), expf(mp - x3)};
            *(GAS f32x4*)(TEMT + o4) = (f32x4){expf(-(b0 + x0)), expf(-(b1 + x1)), expf(-(b2 + x2)), expf(-(b3 + x3))};
            *(GAS f32x4*)(TWK + o4) = (f32x4){expf(a0 - m_loc), expf(a1 - m_loc), expf(a2 - m_loc), expf(a3 - m_loc)};
            if (l == 0) { TCH[(h * 32 + c) * 2] = expf(g + m_st - m_new); TCH[(h * 32 + c) * 2 + 1] = expf(m_loc - m_new); }
        }
        m_st = m_new; lf = lfn; li = lin;
    }
}

__device__ __forceinline__ u32x4 pack8(const f32x4 v0, const f32x4 v1) { u32x4 w; w.x = cvt_pk_bf16(v0.x, v0.y); w.y = cvt_pk_bf16(v0.z, v0.w); w.z = cvt_pk_bf16(v1.x, v1.y); w.w = cvt_pk_bf16(v1.z, v1.w); return w; }
struct EpiQK {
    static constexpr bool PERM = true, AFTER_DRAIN = false, HOOK = false;
    bf16_t *Q, *K, *QS; const float* TIW;
    __device__ __forceinline__ void operator()(const f32x4 (&acc)[2][2][4][2], const Unit& u, int wr, int wc, int fr, int fq) const {
        const int c = u.x, h = u.y, type = u.z;
        bf16_t* dst = (type == 0 ? Q : K) + (size_t)(256 * c) * DM + 256 * h + wc * 32 + 8 * fq;
#pragma unroll
        for (int ai = 0; ai < 2; ++ai)
#pragma unroll
            for (int m = 0; m < 4; ++m) { const int rl = ai * 128 + wr * 64 + m * 16 + fr;
#pragma unroll
                for (int bj = 0; bj < 2; ++bj) *(GAS u32x4*)(dst + (size_t)rl * DM + bj * 128) = pack8(acc[ai][bj][m][0], acc[ai][bj][m][1]); }
        if (type == 0) {
            bf16_t* d2 = QS + (size_t)(h * 32 + c) * 65536 + wc * 32 + 8 * fq; const float* tiw = TIW + (size_t)h * SEQ + 256 * c;
#pragma unroll
            for (int ai = 0; ai < 2; ++ai)
#pragma unroll
                for (int m = 0; m < 4; ++m) { const int rl = ai * 128 + wr * 64 + m * 16 + fr; const float iw = tiw[rl];
#pragma unroll
                    for (int bj = 0; bj < 2; ++bj) *(GAS u32x4*)(d2 + (size_t)rl * 256 + bj * 128) = pack8(acc[ai][bj][m][0] * iw, acc[ai][bj][m][1] * iw); }
        }
    }
};
struct SchedHC2 {
    int b; const char *A0, *A1, *B0, *B1; size_t a_hc_c, a_hc_h, b_hc_c, b_hc_h;
    __device__ __forceinline__ bool next(int i, Unit& u) const { if (i >= 2) return false; u.x = b >> 3; u.y = b & 7; u.z = i; return true; }
    __device__ __forceinline__ const char* aptr(const Unit& u) const { return (u.z ? A1 : A0) + (size_t)u.x * a_hc_c + (size_t)u.y * a_hc_h; }
    __device__ __forceinline__ const char* bptr(const Unit& u) const { return (u.z ? B1 : B0) + (size_t)u.x * b_hc_c + (size_t)u.y * b_hc_h; }
};
struct EpiKWVT {
    static constexpr bool PERM = true, AFTER_DRAIN = false, HOOK = false;
    bf16_t *KWT, *VT; const float* TWK;
    __device__ __forceinline__ void operator()(const f32x4 (&acc)[2][2][4][2], const Unit& u, int wr, int wc, int fr, int fq) const {
        const int c = u.x, h = u.y, type = u.z;
        f32x4 w0[2], w1[2];
#pragma unroll
        for (int bj = 0; bj < 2; ++bj) { const int cl = bj * 128 + wc * 32 + 8 * fq;
            if (type == 0) { w0[bj] = *(const GAS f32x4*)(TWK + (size_t)h * SEQ + 256 * c + cl); w1[bj] = *(const GAS f32x4*)(TWK + (size_t)h * SEQ + 256 * c + cl + 4); }
            else { w0[bj] = (f32x4){1.f, 1.f, 1.f, 1.f}; w1[bj] = w0[bj]; } }
        bf16_t* dst = (type == 0 ? KWT : VT) + (size_t)(h * 32 + c) * 65536;
#pragma unroll
        for (int ai = 0; ai < 2; ++ai)
#pragma unroll
            for (int m = 0; m < 4; ++m) { const int rl = ai * 128 + wr * 64 + m * 16 + fr;
#pragma unroll
                for (int bj = 0; bj < 2; ++bj) { const int cl = bj * 128 + wc * 32 + 8 * fq;
                    *(GAS u32x4*)(dst + (size_t)rl * 256 + cl) = pack8(acc[ai][bj][m][0] * w0[bj], acc[ai][bj][m][1] * w1[bj]); } }
    }
};
struct SchedHC1 {
    int b; const char *A, *B; size_t a_c, a_h, b_c, b_h;
    __device__ __forceinline__ bool next(int i, Unit& u) const { if (i >= 1) return false; u.x = b >> 3; u.y = b & 7; u.z = 0; return true; }
    __device__ __forceinline__ const char* aptr(const Unit& u) const { return A + (size_t)u.x * a_c + (size_t)u.y * a_h; }
    __device__ __forceinline__ const char* bptr(const Unit& u) const { return B + (size_t)u.x * b_c + (size_t)u.y * b_h; }
};
struct EpiCloc {
    static constexpr bool PERM = true, AFTER_DRAIN = false, HOOK = false;
    bf16_t* O;
    __device__ __forceinline__ void operator()(const f32x4 (&acc)[2][2][4][2], const Unit& u, int wr, int wc, int fr, int fq) const {
        bf16_t* dst = O + (size_t)(u.y * 32 + u.x) * 65536;
#pragma unroll
        for (int ai = 0; ai < 2; ++ai)
#pragma unroll
            for (int m = 0; m < 4; ++m) { const int rl = ai * 128 + wr * 64 + m * 16 + fr;
#pragma unroll
                for (int bj = 0; bj < 2; ++bj) { const int cl = bj * 128 + wc * 32 + 8 * fq; *(GAS u32x4*)(dst + (size_t)rl * 256 + cl) = pack8(acc[ai][bj][m][0], acc[ai][bj][m][1]); } }
    }
};
struct EpiS {
    static constexpr bool PERM = true, AFTER_DRAIN = false, HOOK = false;
    bf16_t* Pm; float* DENP; const float *TROW, *TCOL;
    __device__ __forceinline__ void operator()(const f32x4 (&acc)[2][2][4][2], const Unit& u, int wr, int wc, int fr, int fq) const {
        const int c = u.x, h = u.y;
        float tc[2][8];
#pragma unroll
        for (int bj = 0; bj < 2; ++bj) { const int cl = bj * 128 + wc * 32 + 8 * fq; const f32x4 a = *(const GAS f32x4*)(TCOL + (size_t)h * SEQ + 256 * c + cl), b = *(const GAS f32x4*)(TCOL + (size_t)h * SEQ + 256 * c + cl + 4);
            tc[bj][0] = a.x; tc[bj][1] = a.y; tc[bj][2] = a.z; tc[bj][3] = a.w; tc[bj][4] = b.x; tc[bj][5] = b.y; tc[bj][6] = b.z; tc[bj][7] = b.w; }
        bf16_t* dst = Pm + (size_t)(h * 32 + c) * 65536;
#pragma unroll
        for (int ai = 0; ai < 2; ++ai)
#pragma unroll
            for (int m = 0; m < 4; ++m) { const int rl = ai * 128 + wr * 64 + m * 16 + fr; const float tr = TROW[(size_t)h * SEQ + 256 * c + rl]; float s = 0.f;
#pragma unroll
                for (int bj = 0; bj < 2; ++bj) { const int cl = bj * 128 + wc * 32 + 8 * fq; float p[8];
#pragma unroll
                    for (int n = 0; n < 2; ++n)
#pragma unroll
                        for (int e = 0; e < 4; ++e) { const int j = n * 4 + e; const float v = acc[ai][bj][m][n][e] * fexp2(tr + tc[bj][j]); p[j] = (cl + j <= rl) ? v : 0.f; s += p[j]; }
                    u32x4 w; w.x = cvt_pk_bf16(p[0], p[1]); w.y = cvt_pk_bf16(p[2], p[3]); w.z = cvt_pk_bf16(p[4], p[5]); w.w = cvt_pk_bf16(p[6], p[7]);
                    *(GAS u32x4*)(dst + (size_t)rl * 256 + cl) = w; }
                s += __shfl_xor(s, 16); s += __shfl_xor(s, 32);
                if (fq == 0) DENP[((size_t)h * SEQ + 256 * c + rl) * 4 + wc] = s; }
    }
};

struct SchedRG {
    int L; const char *A, *B;
    __device__ __forceinline__ bool next(int i, Unit& u) const { if (i >= 1) return false; u.x = L >> 4; u.y = L & 15; u.z = 0; return true; }
    __device__ __forceinline__ const char* aptr(const Unit& u) const { return A + ((size_t)u.x * 256 * DM + (size_t)(u.y >> 1) * 256) * 2; }
    __device__ __forceinline__ const char* bptr(const Unit& u) const { return B + (size_t)u.y * 256 * 256 * 2; }
};
__device__ __forceinline__ float gelu_tanh(float x) { return x * sigmoidf_(1.5957691216057308f * (x + 0.044715f * x * x * x)); }
template <bool PASS2> struct EpiRG {
    static constexpr bool PERM = false, AFTER_DRAIN = true, HOOK = false;
    const bf16_t* XC; const float *b_a, *b_x, *lam; float *AGGA, *AGGB; const float* CARRY; const bf16_t* GATE; bf16_t* Y;
    __device__ __forceinline__ void fused(f32x4 (&acc)[2][2][4][2], const Unit& u, int wr, int wc, int fr, int fq, LAS unsigned char* lds, int wid, int lane) const {
        constexpr int LDR = 132;
        LAS float* LA = (LAS float*)lds; LAS float* LB = LA + 128 * LDR;
        LAS float* SEGA = (LAS float*)(lds + LDS_AUX); LAS float* SEGB = SEGA + 512; LAS float* CAR = SEGB + 512;
        const int pm = u.x, ch0 = (u.y >> 1) * 256 + (u.y & 1) * 128, tid = threadIdx.x;
        float sp[2][4], ba[2][4], bx[2][4];
#pragma unroll
        for (int nn = 0; nn < 2; ++nn) { const int cg = ch0 + wc * 32 + nn * 16 + 4 * fq;
            const f32x4 l4 = *(const GAS f32x4*)(lam + cg), a4 = *(const GAS f32x4*)(b_a + cg), x4 = *(const GAS f32x4*)(b_x + cg);
#pragma unroll
            for (int e = 0; e < 4; ++e) { sp[nn][e] = 8.0f * log1pf(expf(-l4[e])); ba[nn][e] = a4[e]; bx[nn][e] = x4[e]; } }
        if (tid < 128) CAR[tid] = PASS2 ? CARRY[(size_t)pm * DM + ch0 + tid] : 0.f;
        float prodA = 1.f;
#pragma unroll 1
        for (int ai = 0; ai < 2; ++ai) {
#pragma unroll
            for (int m = 0; m < 4; ++m) { const int rh = wr * 64 + m * 16 + fr; const int t = pm * 256 + ai * 128 + rh;
#pragma unroll
                for (int nn = 0; nn < 2; ++nn) { const int cl = wc * 32 + nn * 16 + 4 * fq;
                    const u32x2 xr = *(const GAS u32x2*)(XC + (size_t)t * DM + ch0 + cl); const float xc[4] = {bf_lo(xr.x), bf_hi(xr.x), bf_lo(xr.y), bf_hi(xr.y)};
                    const f32x4 rp = ai == 0 ? acc[0][0][m][nn] : acc[1][0][m][nn], ip = ai == 0 ? acc[0][1][m][nn] : acc[1][1][m][nn];
                    f32x4 av, bv;
#pragma unroll
                    for (int e = 0; e < 4; ++e) { const float r = sigmoidf_(rp[e] + ba[nn][e]), ig = sigmoidf_(ip[e] + bx[nn][e]);
                        const float la = -r * sp[nn][e], a = fexp2(la * LOG2E), y2 = 2.0f * la;
                        const float ser = -y2 * (1.0f + y2 * (0.5f + y2 * (0.16666667f + y2 * 0.041666668f)));
                        const float om = y2 > -0.02f ? ser : 1.0f - a * a;
                        av[e] = a; bv[e] = sqrtf(om) * ig * xc[e]; }
                    *(LAS f32x4*)(LA + rh * LDR + cl) = av; *(LAS f32x4*)(LB + rh * LDR + cl) = bv; } }
            LDS_WAIT(); __syncthreads();
            const int cl = tid & 127, seg = tid >> 7;
            { float A = 1.f, Bv = 0.f;
#pragma unroll 8
              for (int r = 0; r < 32; ++r) { const float a = LA[(seg * 32 + r) * LDR + cl], bt = LB[(seg * 32 + r) * LDR + cl]; Bv = a * Bv + bt; A *= a; }
              SEGA[seg * 128 + cl] = A; SEGB[seg * 128 + cl] = Bv; }
            LDS_WAIT(); __syncthreads();
            { float hin = CAR[ai * 128 + cl];
              for (int s2 = 0; s2 < seg; ++s2) hin = SEGA[s2 * 128 + cl] * hin + SEGB[s2 * 128 + cl];
              if (PASS2) { float hh = hin;
#pragma unroll 8
                  for (int r = 0; r < 32; ++r) { hh = LA[(seg * 32 + r) * LDR + cl] * hh + LB[(seg * 32 + r) * LDR + cl]; LB[(seg * 32 + r) * LDR + cl] = hh; } }
              if (seg == 3) { CAR[(ai + 1) * 128 + cl] = SEGA[3 * 128 + cl] * hin + SEGB[3 * 128 + cl];
                  prodA *= SEGA[cl] * SEGA[128 + cl] * SEGA[256 + cl] * SEGA[384 + cl]; } }
            LDS_WAIT(); __syncthreads();
            if (PASS2) {
#pragma unroll
                for (int m = 0; m < 4; ++m) { const int rh = wr * 64 + m * 16 + fr; const int t = pm * 256 + ai * 128 + rh;
#pragma unroll
                    for (int nn = 0; nn < 2; ++nn) { const int c2 = wc * 32 + nn * 16 + 4 * fq;
                        const f32x4 hv = *(const LAS f32x4*)(LB + rh * LDR + c2);
                        const u32x2 gr = *(const GAS u32x2*)(GATE + (size_t)t * DM + ch0 + c2);
                        u32x2 o; o.x = cvt_pk_bf16(hv.x * gelu_tanh(bf_lo(gr.x)), hv.y * gelu_tanh(bf_hi(gr.x))); o.y = cvt_pk_bf16(hv.z * gelu_tanh(bf_lo(gr.y)), hv.w * gelu_tanh(bf_hi(gr.y)));
                        *(GAS u32x2*)(Y + (size_t)t * DM + ch0 + c2) = o; } }
                LDS_WAIT(); __syncthreads();
            }
        }
        if (!PASS2) { const int cl = tid & 127; if ((tid >> 7) == 3) { AGGA[(size_t)pm * DM + ch0 + cl] = prodA; AGGB[(size_t)pm * DM + ch0 + cl] = CAR[2 * 128 + cl]; } }
        __syncthreads();
    }
};

struct EpiNum {
    static constexpr bool PERM = true, AFTER_DRAIN = true, HOOK = false;
    const bf16_t* QS; const float *NP, *DENP, *TEMT; const float *mnorm, *mskip; const bf16_t *XCM, *MO; bf16_t* YM;
    __device__ __forceinline__ void fused(f32x4 (&acc)[2][2][4][2], const Unit& u, int wr, int wc, int fr, int fq, LAS unsigned char* lds, int wid, int lane) const {
        const int c = u.x, h = u.y, tid = threadIdx.x;
        LAS float* NPv = (LAS float*)lds; LAS float* RDEN = NPv + 256; LAS f32x2* STAT = (LAS f32x2*)(lds + 2048); LAS f32x2* MR = (LAS f32x2*)(lds + 2048 + 8192);
        if (tid < 256) NPv[tid] = NP[(size_t)(h * 32 + c) * 256 + tid];
        LDS_WAIT(); __syncthreads();
        if (tid < 256) { const bf16_t* qrow = QS + ((size_t)(h * 32 + c) * 256 + tid) * 256; float d = 0.f;
#pragma unroll 4
            for (int k8 = 0; k8 < 32; ++k8) { const u32x4 qv = *(const GAS u32x4*)(qrow + 8 * k8); const LAS float* nv = NPv + 8 * k8;
                d += bf_lo(qv.x) * nv[0] + bf_hi(qv.x) * nv[1] + bf_lo(qv.y) * nv[2] + bf_hi(qv.y) * nv[3] + bf_lo(qv.z) * nv[4] + bf_hi(qv.z) * nv[5] + bf_lo(qv.w) * nv[6] + bf_hi(qv.w) * nv[7]; }
            const size_t tg = (size_t)h * SEQ + 256 * c + tid; const f32x4 dp = *(const GAS f32x4*)(DENP + tg * 4);
            const float den = d + ((dp.x + dp.y) + (dp.z + dp.w));
            RDEN[tid] = 1.0f / fmaxf(fabsf(den), TEMT[tg]); }
        LDS_WAIT(); __syncthreads();
#pragma unroll
        for (int ai = 0; ai < 2; ++ai)
#pragma unroll
            for (int m = 0; m < 4; ++m) { const int rl = ai * 128 + wr * 64 + m * 16 + fr; const float rd = RDEN[rl]; float s = 0.f, q = 0.f;
#pragma unroll
                for (int bj = 0; bj < 2; ++bj)
#pragma unroll
                    for (int n = 0; n < 2; ++n) { f32x4 v = acc[ai][bj][m][n] * rd; acc[ai][bj][m][n] = v; s += (v.x + v.y) + (v.z + v.w); q += (v.x * v.x + v.y * v.y) + (v.z * v.z + v.w * v.w); }
                s += __shfl_xor(s, 16); s += __shfl_xor(s, 32); q += __shfl_xor(q, 16); q += __shfl_xor(q, 32);
                if (fq == 0) STAT[rl * 4 + wc] = (f32x2){s, q}; }
        LDS_WAIT(); __syncthreads();
        if (tid < 256) { const f32x2 a = STAT[tid * 4], b = STAT[tid * 4 + 1], c2 = STAT[tid * 4 + 2], d2 = STAT[tid * 4 + 3];
            const float mu = ((a.x + b.x) + (c2.x + d2.x)) * (1.0f / 256.0f); const float var = fmaxf(((a.y + b.y) + (c2.y + d2.y)) * (1.0f / 256.0f) - mu * mu, 0.f);
            MR[tid] = (f32x2){mu, 1.0f / sqrtf(var + EPS)}; }
        LDS_WAIT(); __syncthreads();
#pragma unroll
        for (int bj = 0; bj < 2; ++bj) { const int cl = bj * 128 + wc * 32 + 8 * fq, cg = 256 * h + cl;
            const f32x4 g0 = *(const GAS f32x4*)(mnorm + cg), g1 = *(const GAS f32x4*)(mnorm + cg + 4), k0 = *(const GAS f32x4*)(mskip + cg), k1 = *(const GAS f32x4*)(mskip + cg + 4);
#pragma unroll
            for (int ai = 0; ai < 2; ++ai)
#pragma unroll
                for (int m = 0; m < 4; ++m) { const int rl = ai * 128 + wr * 64 + m * 16 + fr; const size_t off = (size_t)(256 * c + rl) * DM + cg; const f32x2 mr = MR[rl];
                    const u32x4 xr = *(const GAS u32x4*)(XCM + off), orr = *(const GAS u32x4*)(MO + off);
                    const f32x4 v0 = acc[ai][bj][m][0], v1 = acc[ai][bj][m][1];
                    float y[8];
                    y[0] = ((v0.x - mr.x) * mr.y * g0.x + k0.x * bf_lo(xr.x)) * sigmoidf_(bf_lo(orr.x)); y[1] = ((v0.y - mr.x) * mr.y * g0.y + k0.y * bf_hi(xr.x)) * sigmoidf_(bf_hi(orr.x));
                    y[2] = ((v0.z - mr.x) * mr.y * g0.z + k0.z * bf_lo(xr.y)) * sigmoidf_(bf_lo(orr.y)); y[3] = ((v0.w - mr.x) * mr.y * g0.w + k0.w * bf_hi(xr.y)) * sigmoidf_(bf_hi(orr.y));
                    y[4] = ((v1.x - mr.x) * mr.y * g1.x + k1.x * bf_lo(xr.z)) * sigmoidf_(bf_lo(orr.z)); y[5] = ((v1.y - mr.x) * mr.y * g1.y + k1.y * bf_hi(xr.z)) * sigmoidf_(bf_hi(orr.z));
                    y[6] = ((v1.z - mr.x) * mr.y * g1.z + k1.z * bf_lo(xr.w)) * sigmoidf_(bf_lo(orr.w)); y[7] = ((v1.w - mr.x) * mr.y * g1.w + k1.w * bf_hi(xr.w)) * sigmoidf_(bf_hi(orr.w));
                    u32x4 w; w.x = cvt_pk_bf16(y[0], y[1]); w.y = cvt_pk_bf16(y[2], y[3]); w.z = cvt_pk_bf16(y[4], y[5]); w.w = cvt_pk_bf16(y[6], y[7]);
                    *(GAS u32x4*)(YM + off) = w; } }
        __syncthreads();
    }
};

struct SchedMerge {
    GridOrder go; const char *A0, *A1, *B0, *B1; size_t a_tile, b_tile;
    __device__ __forceinline__ bool next(int i, Unit& u) const { if (i >= 2) return false; int pm, pn; if (!go.tile(0, pm, pn)) return false; u.x = pm; u.y = pn; u.z = i; return true; }
    __device__ __forceinline__ const char* aptr(const Unit& u) const { return (u.z ? A1 : A0) + (size_t)u.x * a_tile; }
    __device__ __forceinline__ const char* bptr(const Unit& u) const { return (u.z ? B1 : B0) + (size_t)u.y * b_tile; }
};
struct EpiMerge {
    static constexpr bool PERM = true, AFTER_DRAIN = false, HOOK = false;
    const bf16_t *GRG, *GM; float* T; bf16_t* O;
    __device__ __forceinline__ void operator()(const f32x4 (&acc)[2][2][4][2], const Unit& u, int wr, int wc, int fr, int fq) const {
        const bf16_t* G = u.z ? GM : GRG;
#pragma unroll
        for (int ai = 0; ai < 2; ++ai)
#pragma unroll
            for (int m = 0; m < 4; ++m) { const int row = u.x * 256 + ai * 128 + wr * 64 + m * 16 + fr;
#pragma unroll
                for (int bj = 0; bj < 2; ++bj) { const size_t off = (size_t)row * DM + u.y * 256 + bj * 128 + wc * 32 + 8 * fq;
                    const u32x4 b = *(const GAS u32x4*)(G + off);
                    const f32x4 s0 = (f32x4){sigmoidf_(bf_lo(b.x)), sigmoidf_(bf_hi(b.x)), sigmoidf_(bf_lo(b.y)), sigmoidf_(bf_hi(b.y))}, s1 = (f32x4){sigmoidf_(bf_lo(b.z)), sigmoidf_(bf_hi(b.z)), sigmoidf_(bf_lo(b.w)), sigmoidf_(bf_hi(b.w))};
                    const f32x4 v0 = acc[ai][bj][m][0] * s0, v1 = acc[ai][bj][m][1] * s1;
                    if (u.z == 0) { *(GAS f32x4*)(T + off) = v0; *(GAS f32x4*)(T + off + 4) = v1; }
                    else { const f32x4 t0 = *(const GAS f32x4*)(T + off), t1 = *(const GAS f32x4*)(T + off + 4); *(GAS u32x4*)(O + off) = pack8(t0 + v0, t1 + v1); } } }
    }
};

__device__ __forceinline__ void state_scan(Frame& F) {
    const bf16_t* CLOC = (const bf16_t*)(F.ws + WS_CLOC); bf16_t* CP = (bf16_t*)(F.ws + WS_CP); const float* TCH = (const float*)(F.ws + WS_TCH);
    const int g = (int)blockIdx.x * 512 + F.tid, h = (int)blockIdx.x >> 5;
    const size_t e0 = (size_t)(g & 16383) * 4;
    float C0 = 0.f, C1 = 0.f, C2 = 0.f, C3 = 0.f;
#pragma unroll 4
    for (int c = 0; c < 32; ++c) { const size_t off = (size_t)(h * 32 + c) * 65536 + e0;
        const u32x2 v = *(const GAS u32x2*)(CLOC + off);
        u32x2 o; o.x = pk2(C0, C1); o.y = pk2(C2, C3); *(GAS u32x2*)(CP + off) = o;
        const float so = TCH[(h * 32 + c) * 2], sl = TCH[(h * 32 + c) * 2 + 1];
        C0 = so * C0 + sl * bf_lo(v.x); C1 = so * C1 + sl * bf_hi(v.x); C2 = so * C2 + sl * bf_lo(v.y); C3 = so * C3 + sl * bf_hi(v.y); }
}
__device__ __forceinline__ void n_scan(Frame& F) {
    const bf16_t* KWT = (const bf16_t*)(F.ws + WS_KWT); float* NP = (float*)(F.ws + WS_NP); const float* TCH = (const float*)(F.ws + WS_TCH);
    const int gw = (int)blockIdx.x * 8 + F.wave, h = gw >> 8, kd = gw & 255;
    float n = 0.f;
#pragma unroll 4
    for (int c = 0; c < 32; ++c) { const u32x2 v = *(const GAS u32x2*)(KWT + ((size_t)(h * 32 + c) * 256 + kd) * 256 + 4 * F.lane);
        const float s = wave_sum((bf_lo(v.x) + bf_hi(v.x)) + (bf_lo(v.y) + bf_hi(v.y)));
        if (F.lane == 0) NP[(size_t)(h * 32 + c) * 256 + kd] = n;
        n = TCH[(h * 32 + c) * 2] * n + TCH[(h * 32 + c) * 2 + 1] * s; }
}
__device__ __forceinline__ void rg_carry(Frame& F) {
    const int g = (int)blockIdx.x * 512 + F.tid; if (g >= DM) return;
    const float* AGGA = (const float*)(F.ws + WS_AGGA); const float* AGGB = (const float*)(F.ws + WS_AGGB); float* CARRY = (float*)(F.ws + WS_CARRY);
    float hh = 0.f;
#pragma unroll 8
    for (int pm = 0; pm < 32; ++pm) { CARRY[(size_t)pm * DM + g] = hh; hh = AGGA[(size_t)pm * DM + g] * hh + AGGB[(size_t)pm * DM + g]; }
}

struct Args { float* out; unsigned char* ws; int ph_lo, ph_hi; int flags, pad; Ptrs p; };


__global__ void __launch_bounds__(512, 2) mega_fwd(Args args) {
    __shared__ __attribute__((aligned(16))) unsigned char lds_raw[LDS_BYTES];
    Frame F;
    F.lds = (LAS unsigned char*)lds_raw;
    F.tid = threadIdx.x; F.lane = F.tid & 63; F.wave = __builtin_amdgcn_readfirstlane(F.tid >> 6);
    F.G = gridDim.x; { const int bx = blockIdx.x; F.vcu = (F.G % 8 == 0) ? (bx % 8) * (F.G / 8) + bx / 8 : bx; }
    F.ws = args.ws; F.H = args.out;
    const Ptrs& P = args.p;
    if (args.flags) { const float c = 100.0f * (float)args.flags; for (size_t i = (size_t)blockIdx.x * 512 + threadIdx.x; i < (size_t)SEQ * DM; i += (size_t)gridDim.x * 512) args.out[i] = c; return; }
    volatile LAS unsigned* lctl = (volatile LAS unsigned*)(F.lds + LDS_CTL);
    if (F.tid < 64) lctl[F.tid] = 0u;
    __syncthreads();
    XcdBarrier bar; bar.bar = (unsigned*)(F.ws + WS_CTL); bar.x = 0; bar.st = lctl + 8;
    bar = xcd_barrier_post((unsigned*)(F.ws + WS_CTL), lctl + 8);
    const int lo = args.ph_lo, hi = args.ph_hi;
#ifndef ONLY_PHASE
#define ONLY_PHASE -1
#endif
#define IN(k) ((ONLY_PHASE < 0 || ONLY_PHASE == (k)) && lo <= (k) && (k) < hi)
#define SEAM(k) do { if (lo <= (k) && (k) + 1 < hi) xcd_barrier(bar); } while (0)

    if (IN(0)) { convert_weights(F, P, 0); p0_wif(F, P.in[6], P.in[5]); p0_rows(F, P.in[0]); }
    SEAM(0);
    if (IN(1)) {
        SchedGrid S; S.go.init(SEQ / 256, FF / 128, F.G, (int)blockIdx.x); S.A = (const char*)(F.ws + WS_XB); S.B = (const char*)(F.ws + WS_W1GU); S.a_tile = (size_t)256 * DM * 2; S.b_tile = (size_t)256 * DM * 2;
        EpiSwiglu E{(bf16_t*)(F.ws + WS_HID1), (const float*)(F.ws + WS_SSQ)};
        pg8::gemm_phase<EpiSwiglu, SchedGrid, true>(F.lds, DM * 2, DM * 2, pg8::kseg_plain(DM), S, E);
    }
    SEAM(1);
    if (IN(2)) {
        SchedGrid S; S.go.init(SEQ / 256, DM / 256, F.G, (int)blockIdx.x); S.A = (const char*)(F.ws + WS_HID1); S.B = (const char*)(F.ws + WS_W1D); S.a_tile = (size_t)256 * FF * 2; S.b_tile = (size_t)256 * FF * 2;
        EpiResid E{P.in[0], F.H, (bf16_t*)(F.ws + WS_XB), (float*)(F.ws + WS_SSQ), 0.5f};
        pg8::gemm_phase<EpiResid, SchedGrid, false>(F.lds, FF * 2, FF * 2, pg8::kseg_plain(FF), S, E);
    }
    SEAM(2);
    if (IN(3)) {
        SchedGrid S; S.go.init(SEQ / 256, 12288 / 256, F.G, (int)blockIdx.x); S.A = (const char*)(F.ws + WS_XB); S.B = (const char*)(F.ws + WS_WIN); S.a_tile = (size_t)256 * DM * 2; S.b_tile = (size_t)256 * DM * 2;
        EpiProj E{(bf16_t*)(F.ws + WS_PROJ), (const float*)(F.ws + WS_SSQ)};
        pg8::gemm_phase<EpiProj, SchedGrid, true>(F.lds, DM * 2, DM * 2, pg8::kseg_plain(DM), S, E);
        thin_gates(F, P.in[19], P.in[20]);
    }
    SEAM(3);
    if (IN(4)) {
        conv_block(F, P, (int)blockIdx.x);
        if (F.wave == 0) gate_prep(F, (int)blockIdx.x & 7, (int)blockIdx.x >> 3);
    }
    SEAM(4);
    if (IN(6)) {
        const int b = (int)blockIdx.x;
#ifndef SUB
#define SUB 0
#endif
        if (SUB == 0 || SUB == 1) { SchedHC2 S; S.b = b; S.A0 = S.A1 = (const char*)(F.ws + WS_XCM); S.B0 = (const char*)(F.ws + WS_WQ); S.B1 = (const char*)(F.ws + WS_WK);
          S.a_hc_c = (size_t)256 * DM * 2; S.a_hc_h = 512; S.b_hc_c = 0; S.b_hc_h = 131072;
          EpiQK E{(bf16_t*)(F.ws + WS_Q), (bf16_t*)(F.ws + WS_K), (bf16_t*)(F.ws + WS_QS), (const float*)(F.ws + WS_TIW)};
          pg8::gemm_phase<EpiQK, SchedHC2, true>(F.lds, DM * 2, 512, pg8::kseg_plain(256), S, E); }
        if (SUB == 0 || SUB == 2) { SchedHC2 S; S.b = b; S.A0 = (const char*)(F.ws + WS_WK); S.A1 = (const char*)(F.ws + WS_WV); S.B0 = (const char*)(F.ws + WS_XCM); S.B1 = (const char*)(F.ws + WS_MX);
          S.a_hc_c = 0; S.a_hc_h = 131072; S.b_hc_c = (size_t)256 * DM * 2; S.b_hc_h = 512;
          EpiKWVT E{(bf16_t*)(F.ws + WS_KWT), (bf16_t*)(F.ws + WS_VT), (const float*)(F.ws + WS_TWK)};
          pg8::gemm_phase<EpiKWVT, SchedHC2, true>(F.lds, 512, DM * 2, pg8::kseg_plain(256), S, E); }
#pragma unroll 1
        for (int r = 0; r < ((SUB == 0 || SUB == 3) ? 2 : 0); ++r) { SchedRG S; S.L = 2 * b + r; S.A = (const char*)(F.ws + WS_XCRG); S.B = (const char*)(F.ws + WS_WRG);
          EpiRG<false> E{(const bf16_t*)(F.ws + WS_XCRG), P.in[10], P.in[12], P.in[13], (float*)(F.ws + WS_AGGA), (float*)(F.ws + WS_AGGB), nullptr, nullptr, nullptr};
          pg8::gemm_phase<EpiRG<false>, SchedRG, false>(F.lds, DM * 2, 512, pg8::kseg_plain(256), S, E); }
    }
    SEAM(6);
    if (IN(7)) {
        const int b = (int)blockIdx.x;
        rg_carry(F);
        if (SUB == 0 || SUB == 1) { SchedHC1 S; S.b = b; S.A = (const char*)(F.ws + WS_VT); S.B = (const char*)(F.ws + WS_KWT); S.a_c = 131072; S.a_h = (size_t)32 * 131072; S.b_c = 131072; S.b_h = (size_t)32 * 131072;
          EpiCloc E{(bf16_t*)(F.ws + WS_CLOC)};
          pg8::gemm_phase<EpiCloc, SchedHC1, false>(F.lds, 512, 512, pg8::kseg_plain(256), S, E); }
        if (SUB == 0 || SUB == 2) { SchedHC1 S; S.b = b; S.A = (const char*)(F.ws + WS_Q); S.B = (const char*)(F.ws + WS_K); S.a_c = (size_t)256 * DM * 2; S.a_h = 512; S.b_c = (size_t)256 * DM * 2; S.b_h = 512;
          EpiS E{(bf16_t*)(F.ws + WS_P), (float*)(F.ws + WS_DENP), (const float*)(F.ws + WS_TROW), (const float*)(F.ws + WS_TCOL)};
          pg8::gemm_phase<EpiS, SchedHC1, false>(F.lds, DM * 2, DM * 2, pg8::kseg_plain(256), S, E); }
    }
    SEAM(7);
    if (IN(8)) {
        const int b = (int)blockIdx.x;
        state_scan(F); n_scan(F);
#pragma unroll 1
        for (int r = 0; r < 2; ++r) { SchedRG S; S.L = 2 * b + r; S.A = (const char*)(F.ws + WS_XCRG); S.B = (const char*)(F.ws + WS_WRG);
          EpiRG<true> E{(const bf16_t*)(F.ws + WS_XCRG), P.in[10], P.in[12], P.in[13], nullptr, nullptr, (const float*)(F.ws + WS_CARRY), (const bf16_t*)(F.ws + WS_RGG), (bf16_t*)(F.ws + WS_YRG)};
          pg8::gemm_phase<EpiRG<true>, SchedRG, false>(F.lds, DM * 2, 512, pg8::kseg_plain(256), S, E); }
    }
    SEAM(8);
    if (IN(9)) {
        const int b = (int)blockIdx.x;
        convert_weights(F, P, 1);
        __syncthreads();
        { SchedHC1 S; S.b = b; S.A = (const char*)(F.ws + WS_P); S.B = (const char*)(F.ws + WS_VT); S.a_c = 131072; S.a_h = (size_t)32 * 131072; S.b_c = 131072; S.b_h = (size_t)32 * 131072;
          KSeg ks; ks.nt = 8; ks.sh = 2; ks.mask = 3u; ks.segA = (long)WS_QS - (long)WS_P; ks.segB = (long)WS_CP - (long)WS_VT;
          EpiNum E{(const bf16_t*)(F.ws + WS_QS), (const float*)(F.ws + WS_NP), (const float*)(F.ws + WS_DENP), (const float*)(F.ws + WS_TEMT), P.in[21], P.in[22], (const bf16_t*)(F.ws + WS_XCM), (const bf16_t*)(F.ws + WS_MO), (bf16_t*)(F.ws + WS_YM)};
          pg8::gemm_phase<EpiNum, SchedHC1, false>(F.lds, 512, 512, ks, S, E); }
    }
    SEAM(9);
    if (IN(10)) {
        SchedMerge S; S.go.init(SEQ / 256, DM / 256, F.G, (int)blockIdx.x); S.A0 = (const char*)(F.ws + WS_YRG); S.A1 = (const char*)(F.ws + WS_YM); S.B0 = (const char*)(F.ws + WS_WPRG); S.B1 = (const char*)(F.ws + WS_WPM);
        S.a_tile = (size_t)256 * DM * 2; S.b_tile = (size_t)256 * DM * 2;
        EpiMerge E{(const bf16_t*)(F.ws + WS_GRG), (const bf16_t*)(F.ws + WS_GM), (float*)(F.ws + WS_TMRG), (bf16_t*)(F.ws + WS_MERGED)};
        pg8::gemm_phase<EpiMerge, SchedMerge, false>(F.lds, DM * 2, DM * 2, pg8::kseg_plain(DM), S, E);
    }
    SEAM(10);
    if (IN(11)) {
        SchedGrid S; S.go.init(SEQ / 256, DM / 256, F.G, (int)blockIdx.x); S.A = (const char*)(F.ws + WS_MERGED); S.B = (const char*)(F.ws + WS_WOUT); S.a_tile = (size_t)256 * DM * 2; S.b_tile = (size_t)256 * DM * 2;
        EpiResid E{F.H, F.H, (bf16_t*)(F.ws + WS_XB), (float*)(F.ws + WS_SSQ), 1.0f};
        pg8::gemm_phase<EpiResid, SchedGrid, false>(F.lds, DM * 2, DM * 2, pg8::kseg_plain(DM), S, E);
    }
    SEAM(11);
    if (IN(12)) {
        SchedGrid S; S.go.init(SEQ / 256, FF / 128, F.G, (int)blockIdx.x); S.A = (const char*)(F.ws + WS_XB); S.B = (const char*)(F.ws + WS_W2GU); S.a_tile = (size_t)256 * DM * 2; S.b_tile = (size_t)256 * DM * 2;
        EpiSwiglu E{(bf16_t*)(F.ws + WS_HID2), (const float*)(F.ws + WS_SSQ)};
        pg8::gemm_phase<EpiSwiglu, SchedGrid, true>(F.lds, DM * 2, DM * 2, pg8::kseg_plain(DM), S, E);
    }
    SEAM(12);
    if (IN(13)) {
        SchedGrid S; S.go.init(SEQ / 256, DM / 256, F.G, (int)blockIdx.x); S.A = (const char*)(F.ws + WS_HID2); S.B = (const char*)(F.ws + WS_W2D); S.a_tile = (size_t)256 * FF * 2; S.b_tile = (size_t)256 * FF * 2;
        EpiResid E{F.H, F.H, nullptr, (float*)(F.ws + WS_SSQ), 0.5f};
        pg8::gemm_phase<EpiResid, SchedGrid, false>(F.lds, FF * 2, FF * 2, pg8::kseg_plain(FF), S, E);
    }
    SEAM(13);
    if (IN(14)) { final_norm(F, P.in[30]); }
#undef IN
#undef SEAM
}

extern "C" void kernel_launch(void* const* d_in, const int* in_sizes, int n_in, void* d_out, int out_size, void* d_ws, size_t ws_size, hipStream_t stream) {
    int flags = 0;
    if (n_in != 31 || out_size != SEQ * DM) flags |= 1;
    if (ws_size < WS_END) flags |= 2;
    { int per_cu = 0; if (hipOccupancyMaxActiveBlocksPerMultiprocessor(&per_cu, (const void*)mega_fwd, 512, 0) != hipSuccess || per_cu < 1) { flags |= 4; (void)hipGetLastError(); } }
    { int dev = 0, cus = 0; if (hipGetDevice(&dev) != hipSuccess || hipDeviceGetAttribute(&cus, hipDeviceAttributeMultiprocessorCount, dev) != hipSuccess || cus != 256) { flags |= 8; (void)hipGetLastError(); } }
    const int grid = 256;
    (void)hipMemsetAsync((char*)d_ws + WS_CTL, 0, CTL_BYTES, stream);
    Args a{};
    for (int i = 0; i < 31; ++i) a.p.in[i] = (const float*)d_in[i];
    a.out = (float*)d_out; a.ws = (unsigned char*)d_ws; a.ph_lo = 0; a.ph_hi = 100; a.flags = flags;
    hipLaunchKernelGGL(mega_fwd, dim3(grid), dim3(512), 0, stream, a);
}
```

```cpp
#include <hip/hip_runtime.h>
#include <cstdio>
#include <cstdint>

#define LAS __attribute__((address_space(3)))
#define GAS __attribute__((address_space(1)))
typedef unsigned short bf16_t;
typedef short bf16x8 __attribute__((ext_vector_type(8)));
typedef float f32x4 __attribute__((ext_vector_type(4)));
typedef float f32x2 __attribute__((ext_vector_type(2)));
typedef unsigned u32x4 __attribute__((ext_vector_type(4)));
typedef unsigned u32x2 __attribute__((ext_vector_type(2)));

constexpr int SEQ = 8192, DM = 2048, FF = 5632, NH = 8, HD = 256, NCH = SEQ / 256;
constexpr int DIN = 12304;
constexpr float EPS = 1e-6f;
constexpr float LOG2E = 1.4426950408889634f;

constexpr size_t MiB = 1u << 20;
constexpr size_t SLOT = 32 * MiB;
#define WS_S(i) ((size_t)(i) * SLOT)
constexpr size_t WS_W1GU = 0, WS_W1D = 44 * MiB, WS_WIN = 66 * MiB;
constexpr size_t WS_XB = WS_S(4);
constexpr size_t WS_HID1 = WS_S(5);
constexpr size_t WS_PROJ = WS_S(5);
constexpr size_t WS_RGX = WS_S(5), WS_RGG = WS_S(6), WS_MX = WS_S(7), WS_MO = WS_S(8), WS_GRG = WS_S(9), WS_GM = WS_S(10);
constexpr size_t WS_XCRG = WS_S(0), WS_XCM = WS_S(1);
constexpr size_t WS_Q = WS_S(2), WS_K = WS_S(3), WS_QS = WS_S(4), WS_VT = WS_S(5), WS_KWT = WS_S(11);
constexpr size_t WS_P = WS_S(7), WS_CLOC = WS_S(12);
constexpr size_t WS_CP = WS_S(2), WS_YRG = WS_S(3);
constexpr size_t WS_W2GU = WS_S(11), WS_W2D = WS_S(11) + 44 * MiB, WS_WPRG = WS_S(11) + 66 * MiB, WS_WPM = WS_S(11) + 74 * MiB, WS_WOUT = WS_S(11) + 82 * MiB;
constexpr size_t WS_YM = WS_S(6), WS_MERGED = WS_S(0);
constexpr size_t WS_HID2 = WS_S(0);
constexpr size_t WS_TMRG = WS_S(1);
constexpr size_t WS_SMALL = WS_S(14);
constexpr size_t WS_CTL = WS_SMALL;
constexpr size_t CTL_BYTES = 64 * 1024;
constexpr size_t WS_WIF = WS_SMALL + 64 * 1024;
constexpr size_t WS_WRG = WS_SMALL + 1 * MiB;
constexpr size_t WS_WQ = WS_SMALL + 3 * MiB, WS_WK = WS_SMALL + 4 * MiB, WS_WV = WS_SMALL + 5 * MiB;
constexpr size_t WS_SSQ = WS_SMALL + 6 * MiB;
constexpr size_t WS_LOGI = WS_SSQ + 256 * 1024, WS_LOGF = WS_LOGI + 256 * 1024;
constexpr size_t WS_TWK = WS_LOGF + 256 * 1024, WS_TCOL = WS_TWK + 256 * 1024, WS_TROW = WS_TCOL + 256 * 1024, WS_TIW = WS_TROW + 256 * 1024, WS_TEMT = WS_TIW + 256 * 1024;
constexpr size_t WS_TCH = WS_TEMT + 256 * 1024;
constexpr size_t WS_AGGA = WS_TCH + 64 * 1024, WS_AGGB = WS_AGGA + 256 * 1024;
constexpr size_t WS_DENP = WS_AGGB + 256 * 1024;
constexpr size_t WS_NP = WS_DENP + 1 * MiB;
constexpr size_t WS_CARRY = WS_NP + 256 * 1024;
constexpr size_t WS_END = WS_CARRY + 256 * 1024;

#ifndef LDS_TEST
#define LDS_TEST 0
#endif
#ifndef NO_BARRIER
#define NO_BARRIER 0
#endif
#ifndef SKEL_XONLY
#define SKEL_XONLY 0
#endif
constexpr int RING_BYTES = 131072;
constexpr int LDS_AUX = 135168;
constexpr int LDS_CTL = LDS_TEST ? 16384 : 143360;
constexpr int LDS_BYTES = LDS_TEST ? 32768 : 147456;

#define LDS_WAIT() asm volatile("s_waitcnt lgkmcnt(0)" ::: "memory")
#define VM_WAIT() asm volatile("s_waitcnt vmcnt(0)" ::: "memory")

__device__ __forceinline__ unsigned f2bf(float f) { unsigned u = __builtin_bit_cast(unsigned, f); return (u + 0x7fffu + ((u >> 16) & 1u)) >> 16; }
__device__ __forceinline__ unsigned pk2(float lo, float hi) { return f2bf(lo) | (f2bf(hi) << 16); }
__device__ __forceinline__ float bf_lo(unsigned u) { return __builtin_bit_cast(float, u << 16); }
__device__ __forceinline__ float bf_hi(unsigned u) { return __builtin_bit_cast(float, u & 0xffff0000u); }
__device__ __forceinline__ unsigned cvt_pk_bf16(float lo, float hi) { unsigned r; asm volatile("v_cvt_pk_bf16_f32 %0, %1, %2" : "=v"(r) : "v"(lo), "v"(hi)); return r; }
__device__ __forceinline__ float fexp2(float x) { return __builtin_amdgcn_exp2f(x); }
__device__ __forceinline__ float frcp(float x) { return __builtin_amdgcn_rcpf(x); }
__device__ __forceinline__ float sigmoidf_(float x) { return frcp(1.0f + fexp2(-x * LOG2E)); }
__device__ __forceinline__ float wave_sum(float v) {
#pragma unroll
    for (int o = 1; o < 64; o <<= 1) v += __shfl_xor(v, o);
    return v;
}

namespace pg8 {
constexpr int BM = 256, BK = 64, HALF = 128, HTB = HALF * BK * 2, STAGE_BYTES = 8 * HTB, NXCD = 8, WGM = 8;
__host__ __device__ __forceinline__ int lds_byte(int r, int c) { const int st = (r >> 4) * 2 + (c >> 5), rr = r & 15, cc = c & 31, ob = rr * 64 + cc * 2; return st * 1024 + (ob ^ (((ob >> 9) & 1) << 5)); }
__host__ __device__ __forceinline__ void stage_rc(int b, int& R, int& C) { const int st = b / 1024, sb = b % 1024, swz = sb ^ (((sb >> 9) & 1) << 5); R = (st >> 1) * 16 + swz / 64; C = (st & 1) * 32 + (swz % 64) / 2; }
__host__ __device__ __forceinline__ int perm32(int rho) { const int n = rho >> 4, i = rho & 15; return 8 * (i >> 2) + 4 * n + (i & 3); }

struct Unit { int x, y, z; };
struct KSeg { int nt, sh; unsigned mask; long segA, segB; };
__host__ __device__ __forceinline__ KSeg kseg_plain(int K) { KSeg k; k.nt = K / BK; k.sh = 30; k.mask = 0x3fffffffu; k.segA = 0; k.segB = 0; return k; }

struct GridOrder {
    int nM, nN, nwg, G, c;
    __device__ void init(int nM_, int nN_, int G_, int c_) { nM = nM_; nN = nN_; nwg = nM * nN; G = G_; c = c_; }
    __device__ bool tile(int i, int& pm, int& pn) const {
        const long L = (long)i * G + c; if (L >= nwg) return false;
        int wgid = (int)L; { const int q = nwg / NXCD, r = nwg % NXCD, xcd = wgid % NXCD, off = wgid / NXCD; wgid = (xcd < r ? xcd * (q + 1) : r * (q + 1) + (xcd - r) * q) + off; }
        const int nig = WGM * nN, gid = wgid / nig, fm = gid * WGM, gsz = (nM - fm) < WGM ? (nM - fm) : WGM;
        pm = fm + ((wgid % nig) % gsz); pn = (wgid % nig) / gsz; return true;
    }
};

template <class Epi, class Sched, bool ALIGN_EPI = false>
__device__ __forceinline__ void gemm_phase(LAS unsigned char* lds, const unsigned lda, const unsigned ldb, const KSeg ks, const Sched& S, const Epi& E) {
    int tid_ = threadIdx.x; asm volatile("" : "+v"(tid_));
    const int tid = tid_, wid = __builtin_amdgcn_readfirstlane(tid >> 6), lane = tid & 63, wr = wid >> 2, wc = wid & 3, fr = lane & 15, fq = lane >> 4;
    const int nt = ks.nt;
    unsigned voffA[2], voffB[2];
#pragma unroll
    for (int i = 0; i < 2; ++i) { int R, C; stage_rc(tid * 16 + i * 8192, R, C); const int Rb = Epi::PERM ? ((R & ~31) + perm32(R & 31)) : R;
        voffA[i] = (unsigned)R * lda + (unsigned)C * 2u; voffB[i] = (unsigned)Rb * ldb + (unsigned)C * 2u; }
    const size_t hstepA = (size_t)HALF * lda, hstepB = (size_t)HALF * ldb;
    const unsigned ldsw = (unsigned)wid * 1024u;
    const int aoff = lds_byte(wr * 64 + fr, fq * 8), boff = lds_byte(wc * 32 + fr, fq * 8);
#define PG8_KA(t) ((long)((t) >> ks.sh) * ks.segA + (long)((unsigned)(t) & ks.mask) * 128)
#define PG8_KB(t) ((long)((t) >> ks.sh) * ks.segB + (long)((unsigned)(t) & ks.mask) * 128)
#define PG8_SA(b, h) (((b) * 2 + (h)) * HTB)
#define PG8_SB(b, h) ((4 + (b) * 2 + (h)) * HTB)
#define PG8_STAGE(bufoff, gbase, voff) do { _Pragma("unroll") for (int _i = 0; _i < 2; ++_i) \
        __builtin_amdgcn_global_load_lds((const unsigned*)((const char*)(gbase) + (voff)[_i]), (LAS unsigned*)(lds + (bufoff) + ldsw + _i * 8192), 16, 0, 0); } while (0)
#define PG8_LDA(dst, b, h) do { _Pragma("unroll") for (int m = 0; m < 4; ++m) _Pragma("unroll") for (int k = 0; k < 2; ++k) dst[m][k] = *(const LAS bf16x8*)(lds + PG8_SA(b, h) + aoff + m * 2048 + k * 1024); } while (0)
#define PG8_LDB(dst, b, h) do { _Pragma("unroll") for (int n = 0; n < 2; ++n) _Pragma("unroll") for (int k = 0; k < 2; ++k) dst[n][k] = *(const LAS bf16x8*)(lds + PG8_SB(b, h) + boff + n * 2048 + k * 1024); } while (0)
#define PG8_MMA(ai, bj, At, Bt) do { __builtin_amdgcn_s_setprio(1); _Pragma("unroll") for (int m = 0; m < 4; ++m) _Pragma("unroll") for (int n = 0; n < 2; ++n) _Pragma("unroll") for (int k = 0; k < 2; ++k) \
        acc[ai][bj][m][n] = __builtin_amdgcn_mfma_f32_16x16x32_bf16(Bt[n][k], At[m][k], acc[ai][bj][m][n], 0, 0, 0); __builtin_amdgcn_s_setprio(0); } while (0)
#define PG8_WAIT_V(n) asm volatile("s_waitcnt vmcnt(" #n ")" ::: "memory")
#define PG8_WAIT_L(n) asm volatile("s_waitcnt lgkmcnt(" #n ")" ::: "memory")
#define PG8_BAR __builtin_amdgcn_s_barrier()
#define PG8_SCHED __builtin_amdgcn_sched_barrier(0)
    Unit cur, nxt; int ui = 0;
    if (!S.next(0, cur)) return;
    f32x4 acc[2][2][4][2];
#pragma unroll
    for (int a = 0; a < 2; ++a)
#pragma unroll
        for (int b = 0; b < 2; ++b)
#pragma unroll
            for (int m = 0; m < 4; ++m)
#pragma unroll
                for (int n = 0; n < 2; ++n) acc[a][b][m][n] = (f32x4){0.f, 0.f, 0.f, 0.f};
    bf16x8 At[4][2], B0[2][2], B1[2][2];
    const char* cA = S.aptr(cur); const char* cB = S.bptr(cur);
    {
        const long ka1 = PG8_KA(1), kb1 = PG8_KB(1);
        PG8_STAGE(PG8_SB(0, 0), cB, voffB); PG8_STAGE(PG8_SB(0, 1), cB + hstepB, voffB); PG8_STAGE(PG8_SA(0, 0), cA, voffA); PG8_STAGE(PG8_SA(0, 1), cA + hstepA, voffA);
        if (wr == 1) PG8_BAR;
        PG8_WAIT_V(2); PG8_BAR;
        PG8_STAGE(PG8_SB(1, 0), cB + kb1, voffB); PG8_STAGE(PG8_SA(1, 0), cA + ka1, voffA); PG8_STAGE(PG8_SB(1, 1), cB + hstepB + kb1, voffB);
        PG8_WAIT_V(6); PG8_BAR;
    }
    for (;;) {
        const bool has_next = S.next(ui + 1, nxt);
        const char* nA = has_next ? S.aptr(nxt) : cA; const char* nB = has_next ? S.bptr(nxt) : cB;
#pragma unroll 1
        for (int t = 0; t < nt; t += 2) {
            const bool last = (t == nt - 2);
            if constexpr (Epi::HOOK) { if (t == E.hook_t) E.hook(acc, cur, wr, wc, fr, fq); }
            const char* a1 = cA + PG8_KA(t + 1);
            const char* a2 = last ? nA : cA + PG8_KA(t + 2); const char* b2 = last ? nB : cB + PG8_KB(t + 2);
            const char* a3 = last ? nA + PG8_KA(1) : cA + PG8_KA(t + 3); const char* b3 = last ? nB + PG8_KB(1) : cB + PG8_KB(t + 3);
            PG8_LDB(B0, 0, 0); PG8_LDB(B1, 0, 1); PG8_SCHED; PG8_LDA(At, 0, 0); PG8_STAGE(PG8_SA(1, 1), a1 + hstepA, voffA);
            PG8_WAIT_V(8); PG8_WAIT_L(0); PG8_BAR; PG8_MMA(0, 0, At, B0); PG8_MMA(0, 1, At, B1); PG8_BAR; PG8_SCHED;
            PG8_LDA(At, 0, 1); PG8_STAGE(PG8_SB(0, 0), b2, voffB); PG8_STAGE(PG8_SB(0, 1), b2 + hstepB, voffB); PG8_STAGE(PG8_SA(0, 0), a2, voffA);
            PG8_WAIT_V(8); PG8_WAIT_L(0); PG8_BAR; PG8_MMA(1, 0, At, B0); PG8_MMA(1, 1, At, B1); PG8_BAR; PG8_SCHED;
            PG8_LDB(B0, 1, 0); PG8_LDB(B1, 1, 1); PG8_SCHED; PG8_LDA(At, 1, 0); PG8_STAGE(PG8_SA(0, 1), a2 + hstepA, voffA);
            PG8_WAIT_V(8); PG8_WAIT_L(0); PG8_BAR; PG8_MMA(0, 0, At, B0); PG8_MMA(0, 1, At, B1); PG8_BAR; PG8_SCHED;
            PG8_LDA(At, 1, 1); PG8_STAGE(PG8_SB(1, 0), b3, voffB); PG8_STAGE(PG8_SB(1, 1), b3 + hstepB, voffB); PG8_STAGE(PG8_SA(1, 0), a3, voffA);
            PG8_WAIT_V(8); PG8_WAIT_L(0); PG8_BAR; PG8_MMA(1, 0, At, B0); PG8_MMA(1, 1, At, B1); PG8_BAR; PG8_SCHED;
        }
        if constexpr (ALIGN_EPI) { if (wr == 0) PG8_BAR; }
        if constexpr (!Epi::AFTER_DRAIN) { int fr_ = fr, fq_ = fq; asm volatile("" : "+v"(fr_), "+v"(fq_)); E(acc, cur, wr, wc, fr_, fq_); }
        if (!has_next) break;
#pragma unroll
        for (int a = 0; a < 2; ++a)
#pragma unroll
            for (int b = 0; b < 2; ++b)
#pragma unroll
                for (int m = 0; m < 4; ++m)
#pragma unroll
                    for (int n = 0; n < 2; ++n) acc[a][b][m][n] = (f32x4){0.f, 0.f, 0.f, 0.f};
        cur = nxt; cA = nA; cB = nB; ++ui;
        if constexpr (ALIGN_EPI) { if (wr == 1) PG8_BAR; }
    }
    PG8_WAIT_V(0);
    if constexpr (!ALIGN_EPI) { if (wr == 0) PG8_BAR; }
    PG8_BAR;
    if constexpr (Epi::AFTER_DRAIN) { int fr_ = fr, fq_ = fq, lane_ = lane; asm volatile("" : "+v"(fr_), "+v"(fq_), "+v"(lane_)); E.fused(acc, cur, wr, wc, fr_, fq_, lds, wid, lane_); }
#undef PG8_KA
#undef PG8_KB
#undef PG8_SA
#undef PG8_SB
#undef PG8_STAGE
#undef PG8_LDA
#undef PG8_LDB
#undef PG8_MMA
#undef PG8_WAIT_V
#undef PG8_WAIT_L
#undef PG8_BAR
#undef PG8_SCHED
}
}
using pg8::Unit; using pg8::KSeg; using pg8::GridOrder;

#define XB_TMO      128
#define XB_XCNT(j)  (256  + 64 * (j))
#define XB_XSUB(j)  (1280 + 64 * (j))
#define XB_XGEN(j)  (2304 + 64 * (j))
#define XB_TOP      3328
#define XB_TOPGEN   3392
#define XCD_BAR_WORDS 3456
#define XB_SPIN_CAP (1u << 18)
__device__ __forceinline__ unsigned xb_ld(unsigned* p)              { return __hip_atomic_load(p, __ATOMIC_RELAXED, __HIP_MEMORY_SCOPE_AGENT); }
__device__ __forceinline__ unsigned xb_add(unsigned* p, unsigned v) { return __hip_atomic_fetch_add(p, v, __ATOMIC_RELAXED, __HIP_MEMORY_SCOPE_AGENT); }
__device__ __forceinline__ unsigned xb_xcc_id() { return (unsigned)__builtin_amdgcn_s_getreg((3 << 11) | 20) & 0xFu; }
#define XB_SPIN(cond, bar) do { unsigned _sp = 0; while (cond) { __builtin_amdgcn_s_sleep(1); \
    if ((++_sp & 255u) == 0u) { if (xb_ld(&(bar)[XB_TMO])) break; if (_sp > XB_SPIN_CAP) { atomicAdd(&(bar)[XB_TMO], 1u); break; } } } } while (0)
struct XcdBarrier { unsigned* bar; unsigned x; volatile LAS unsigned* st; };
__device__ __forceinline__ XcdBarrier xcd_barrier_post(unsigned* bar, volatile LAS unsigned* st) {
    XcdBarrier b; b.bar = bar; b.x = xb_xcc_id(); b.st = st;
    if (threadIdx.x == 0) (void)xb_add(&bar[XB_XCNT(b.x)], 1u);
    return b;
}
__device__ __forceinline__ void xcd_barrier_complete(unsigned* bar, unsigned x, unsigned& nloc, unsigned& nx) {
    const unsigned G = gridDim.x * gridDim.y * gridDim.z;
    unsigned sum, cnt, mine, sp = 0u;
    for (;;) {
        sum = 0u; cnt = 0u; mine = 0u;
#pragma unroll
        for (unsigned j = 0; j < 16; ++j) { const unsigned c = xb_ld(&bar[XB_XCNT(j)]); sum += c; cnt += (c > 0u) ? 1u : 0u; mine = (j == x) ? c : mine; }
        if (sum == G) break;
        __builtin_amdgcn_s_sleep(1);
        if ((++sp & 255u) == 0u) { if (xb_ld(&bar[XB_TMO])) break; if (sp > XB_SPIN_CAP) { atomicAdd(&bar[XB_TMO], 1u); break; } }
    }
    nloc = mine > 0u ? mine : 1u; nx = cnt > 0u ? cnt : 1u;
}
__device__ __forceinline__ void xcd_barrier(const XcdBarrier& b) {
    asm volatile("s_waitcnt vmcnt(0)" ::: "memory");
    __syncthreads();
    if (threadIdx.x == 0) {
        unsigned* bar = b.bar;
        __builtin_amdgcn_s_waitcnt(0);
        unsigned nloc = b.st[0], nx = b.st[1];
        if (nloc == 0u) { xcd_barrier_complete(bar, b.x, nloc, nx); b.st[0] = nloc; b.st[1] = nx; }
        const unsigned old = xb_add(&bar[XB_XSUB(b.x)], 1u);
        const unsigned gen = old / nloc;
        if (old + 1u == (gen + 1u) * nloc) {
            __builtin_amdgcn_fence(__ATOMIC_RELEASE, "agent");
            asm volatile("s_waitcnt vmcnt(0)" ::: "memory");
            const unsigned og = xb_add(&bar[XB_TOP], 1u);
            const unsigned tg = og / nx;
            if (og + 1u == (tg + 1u) * nx) xb_add(&bar[XB_TOPGEN], 1u);
            else XB_SPIN(xb_ld(&bar[XB_TOPGEN]) == tg, bar);
            __builtin_amdgcn_fence(__ATOMIC_ACQUIRE, "agent");
            xb_add(&bar[XB_XGEN(b.x)], 1u);
            asm volatile("s_waitcnt vmcnt(0)" ::: "memory");
        } else {
            XB_SPIN(xb_ld(&bar[XB_XGEN(b.x)]) == gen, bar);
            __builtin_amdgcn_fence(__ATOMIC_ACQUIRE, "agent");
            asm volatile("s_waitcnt vmcnt(0)" ::: "memory");
        }
    }
    __syncthreads();
}

struct Frame {
    LAS unsigned char* lds;
    int tid, lane, wave, vcu, G;
    unsigned char* ws;
    float* H;
};

struct TJob { const float* W; int ldw, K, N; bf16_t* WT; int ldt, row_off, rs128; const float* ksc; float mul; };
__device__ __forceinline__ void transpose_item(const TJob& j, LAS float* scr  , int item, int lane) {
    const int nblk = j.N >> 6, kb = item / nblk, nb = item - kb * nblk, k0 = 64 * kb, n0 = 64 * nb;
    const int r = lane >> 4, c4 = (lane & 15) * 4;
    f32x4 v[16];
    const float* src = j.W + (size_t)(k0 + r) * j.ldw + n0 + c4;
#pragma unroll
    for (int i = 0; i < 16; ++i) v[i] = *(const GAS f32x4*)(src + (size_t)(4 * i) * j.ldw);
#pragma unroll
    for (int i = 0; i < 16; ++i) { const int kk = 4 * i + r; const float sc = j.ksc ? j.ksc[k0 + kk] * j.mul : j.mul; LAS float* d = scr + kk * 65 + c4;
        d[0] = v[i].x * sc; d[1] = v[i].y * sc; d[2] = v[i].z * sc; d[3] = v[i].w * sc; }
    LDS_WAIT(); asm volatile("" ::: "memory");
    const int c = lane & 7;
    const int drow0 = j.row_off + (n0 >> 7) * j.rs128 + (n0 & 127);
#pragma unroll
    for (int q = 0; q < 8; ++q) { const int n = (lane >> 3) + 8 * q; const LAS float* s = scr + (8 * c) * 65 + n;
        u32x4 o; o.x = pk2(s[0 * 65], s[1 * 65]); o.y = pk2(s[2 * 65], s[3 * 65]); o.z = pk2(s[4 * 65], s[5 * 65]); o.w = pk2(s[6 * 65], s[7 * 65]);
        *(GAS u32x4*)(j.WT + (size_t)(drow0 + n) * j.ldt + k0 + 8 * c) = o; }
    LDS_WAIT(); asm volatile("" ::: "memory");
}

struct Ptrs { const float* in[31]; };

__device__ __forceinline__ bool get_job(const Ptrs& P, unsigned char* ws, int stage, int it, TJob& j, int& item) {
    int r = it;
    if (stage == 0) {
        constexpr int I_GU = (DM / 64) * (FF / 64), I_D = (FF / 64) * (DM / 64), I_IN = (DM / 64) * (12288 / 64), I_B = (256 / 64) * (256 / 64);
        if (r < I_GU) { j = TJob{P.in[2], FF, DM, FF, (bf16_t*)(ws + WS_W1GU), DM, 0, 256, P.in[1], 1.f}; item = r; return true; } r -= I_GU;
        if (r < I_GU) { j = TJob{P.in[3], FF, DM, FF, (bf16_t*)(ws + WS_W1GU), DM, 128, 256, P.in[1], 1.f}; item = r; return true; } r -= I_GU;
        if (r < I_D) { j = TJob{P.in[4], DM, FF, DM, (bf16_t*)(ws + WS_W1D), FF, 0, 128, nullptr, 1.f}; item = r; return true; } r -= I_D;
        if (r < I_IN) { j = TJob{P.in[6], DIN, DM, 12288, (bf16_t*)(ws + WS_WIN), DM, 0, 128, P.in[5], 1.f}; item = r; return true; } r -= I_IN;
        if (r < 16 * I_B) { const int b = r / I_B, blk = b >> 1, which = b & 1; j = TJob{P.in[which ? 11 : 9] + (size_t)blk * 65536, 256, 256, 256, (bf16_t*)(ws + WS_WRG), 256, blk * 512 + which * 128, 256, nullptr, 1.f}; item = r % I_B; return true; } r -= 16 * I_B;
        if (r < 24 * I_B) { const int b = r / I_B, which = b >> 3, h = b & 7;
            j = TJob{P.in[16 + which] + (size_t)h * 65536, 256, 256, 256, (bf16_t*)(ws + (which == 0 ? WS_WQ : which == 1 ? WS_WK : WS_WV)), 256, h * 256, 128, nullptr, which == 1 ? 0.0625f : 1.f}; item = r % I_B; return true; }
        return false;
    } else {
        constexpr int I_GU = (DM / 64) * (FF / 64), I_D = (FF / 64) * (DM / 64), I_SQ = (DM / 64) * (DM / 64);
        if (r < I_GU) { j = TJob{P.in[27], FF, DM, FF, (bf16_t*)(ws + WS_W2GU), DM, 0, 256, P.in[26], 1.f}; item = r; return true; } r -= I_GU;
        if (r < I_GU) { j = TJob{P.in[28], FF, DM, FF, (bf16_t*)(ws + WS_W2GU), DM, 128, 256, P.in[26], 1.f}; item = r; return true; } r -= I_GU;
        if (r < I_D) { j = TJob{P.in[29], DM, FF, DM, (bf16_t*)(ws + WS_W2D), FF, 0, 128, nullptr, 1.f}; item = r; return true; } r -= I_D;
        if (r < I_SQ) { j = TJob{P.in[23], DM, DM, DM, (bf16_t*)(ws + WS_WPRG), DM, 0, 128, nullptr, 1.f}; item = r; return true; } r -= I_SQ;
        if (r < I_SQ) { j = TJob{P.in[24], DM, DM, DM, (bf16_t*)(ws + WS_WPM), DM, 0, 128, nullptr, 1.f}; item = r; return true; } r -= I_SQ;
        if (r < I_SQ) { j = TJob{P.in[25], DM, DM, DM, (bf16_t*)(ws + WS_WOUT), DM, 0, 128, nullptr, 1.f}; item = r; return true; }
        return false;
    }
}
__device__ __forceinline__ void convert_weights(Frame& F, const Ptrs& P, int stage) {
    LAS float* scr = (LAS float*)(F.lds + F.wave * 16640);
    const int gw = F.vcu * 8 + F.wave, NGW = F.G * 8;
    for (int it = gw;; it += NGW) { TJob j; int item; if (!get_job(P, F.ws, stage, it, j, item)) break; transpose_item(j, scr, item, F.lane); }
}

__device__ __forceinline__ void p0_rows(Frame& F, const float* x) {
    const int gw = F.vcu * 8 + F.wave, NGW = F.G * 8;
    bf16_t* XB = (bf16_t*)(F.ws + WS_XB); float* SSQ = (float*)(F.ws + WS_SSQ);
    for (int m = gw; m < SEQ; m += NGW) {
        const GAS f32x4* xr = (const GAS f32x4*)(x + (size_t)m * DM) + F.lane;
        GAS u32x2* o8 = (GAS u32x2*)(XB + (size_t)m * DM) + F.lane;
        float s = 0.f;
#pragma unroll
        for (int j = 0; j < 8; ++j) { const f32x4 v = xr[64 * j]; s += (v.x * v.x + v.y * v.y) + (v.z * v.z + v.w * v.w); u32x2 w; w.x = pk2(v.x, v.y); w.y = pk2(v.z, v.w); o8[64 * j] = w; }
        s = wave_sum(s);
        if (F.lane < 8) SSQ[(size_t)m * 8 + F.lane] = F.lane == 0 ? s : 0.f;
#if 0
        { GAS f32x4* hr = (GAS f32x4*)(F.H + (size_t)m * DM) + F.lane;
#pragma unroll
          for (int j = 0; j < 8; ++j) hr[64 * j] = xr[64 * j]; }
#endif
    }
}
__device__ __forceinline__ void p0_wif(Frame& F, const float* w_in, const float* mix_norm) {
    const int g = (int)blockIdx.x * 512 + F.tid; if (g >= 16 * DM) return;
    const int j = g >> 11, k = g & 2047;
    ((bf16_t*)(F.ws + WS_WIF))[g] = (bf16_t)f2bf(w_in[(size_t)k * DIN + 12288 + j] * mix_norm[k]);
}

__device__ __forceinline__ void final_norm(Frame& F, const float* g) {
    const int gw = F.vcu * 8 + F.wave, NGW = F.G * 8;
    for (int m = gw; m < SEQ; m += NGW) {
        GAS f32x4* xr = (GAS f32x4*)(F.H + (size_t)m * DM) + F.lane;
        f32x4 v[8]; float s = 0.f;
#pragma unroll
        for (int j = 0; j < 8; ++j) { v[j] = xr[64 * j]; s += (v[j].x * v[j].x + v[j].y * v[j].y) + (v[j].z * v[j].z + v[j].w * v[j].w); }
        const float rs = 1.0f / sqrtf(wave_sum(s) * (1.0f / DM) + EPS);
#pragma unroll
        for (int j = 0; j < 8; ++j) { const f32x4 gg = *((const GAS f32x4*)g + F.lane + 64 * j); xr[64 * j] = v[j] * rs * gg; }
    }
}

__device__ __forceinline__ float row_rs(const float* SSQ, int row) {
    const f32x4 a = *(const GAS f32x4*)(SSQ + (size_t)row * 8), b = *(const GAS f32x4*)(SSQ + (size_t)row * 8 + 4);
    const float s = ((a.x + a.y) + (a.z + a.w)) + ((b.x + b.y) + (b.z + b.w));
    return 1.0f / sqrtf(s * (1.0f / DM) + EPS);
}

struct EpiSwiglu {
    static constexpr bool PERM = true, AFTER_DRAIN = false, HOOK = false;
    bf16_t* O; const float* SSQ;
    __device__ __forceinline__ void operator()(const f32x4 (&acc)[2][2][4][2], const Unit& u, int wr, int wc, int fr, int fq) const {
        const int col0 = u.y * 128 + wc * 32 + 8 * fq;
#pragma unroll
        for (int ai = 0; ai < 2; ++ai)
#pragma unroll
            for (int m = 0; m < 4; ++m) { const int row = u.x * 256 + ai * 128 + wr * 64 + m * 16 + fr; const float rs = row_rs(SSQ, row);
                float o[8];
#pragma unroll
                for (int n = 0; n < 2; ++n)
#pragma unroll
                    for (int e = 0; e < 4; ++e) { const float g = acc[ai][0][m][n][e] * rs, up = acc[ai][1][m][n][e] * rs; o[n * 4 + e] = g * sigmoidf_(g) * up; }
                u32x4 w; w.x = cvt_pk_bf16(o[0], o[1]); w.y = cvt_pk_bf16(o[2], o[3]); w.z = cvt_pk_bf16(o[4], o[5]); w.w = cvt_pk_bf16(o[6], o[7]);
                *(GAS u32x4*)(O + (size_t)row * FF + col0) = w; }
    }
};
struct SchedGrid {
    GridOrder go; const char* A; const char* B; size_t a_tile, b_tile;
    __device__ __forceinline__ bool next(int i, Unit& u) const { int pm, pn; if (!go.tile(i, pm, pn)) return false; u.x = pm; u.y = pn; u.z = 0; return true; }
    __device__ __forceinline__ const char* aptr(const Unit& u) const { return A + (size_t)u.x * a_tile; }
    __device__ __forceinline__ const char* bptr(const Unit& u) const { return B + (size_t)u.y * b_tile; }
};

struct EpiResid {
    static constexpr bool PERM = false, AFTER_DRAIN = true, HOOK = false;
    const float* resid; float* H; bf16_t* XB; float* SSQ; float scale;
    __device__ __forceinline__ void fused(f32x4 (&acc)[2][2][4][2], const Unit& u, int wr, int wc, int fr, int fq, LAS unsigned char* lds, int wid, int lane) const {
        LAS float* Pp = (LAS float*)lds;
        const int col0 = u.y * 256 + wc * 32 + 4 * fq;
#pragma unroll
        for (int ai = 0; ai < 2; ++ai)
#pragma unroll
            for (int m = 0; m < 4; ++m) { const int rl = ai * 128 + wr * 64 + m * 16 + fr; const size_t off = (size_t)(u.x * 256 + rl) * DM + col0; float s = 0.f;
#pragma unroll
                for (int bj = 0; bj < 2; ++bj)
#pragma unroll
                    for (int n = 0; n < 2; ++n) { const size_t o2 = off + bj * 128 + n * 16; const f32x4 r = *(const GAS f32x4*)(resid + o2); const f32x4 h = r + acc[ai][bj][m][n] * scale;
                        *(GAS f32x4*)(H + o2) = h; s += (h.x * h.x + h.y * h.y) + (h.z * h.z + h.w * h.w);
                        if (XB) { u32x2 w; w.x = cvt_pk_bf16(h.x, h.y); w.y = cvt_pk_bf16(h.z, h.w); *(GAS u32x2*)(XB + o2) = w; } }
                s += __shfl_xor(s, 16); s += __shfl_xor(s, 32);
                if (fq == 0) Pp[rl * 4 + wc] = s; }
        LDS_WAIT(); __syncthreads();
        const int t = threadIdx.x;
        if (t < 256) { const f32x4 p = *(const LAS f32x4*)(Pp + t * 4); SSQ[(size_t)(u.x * 256 + t) * 8 + u.y] = (p.x + p.y) + (p.z + p.w); }
        __syncthreads();
    }
};

struct EpiProj {
    static constexpr bool PERM = true, AFTER_DRAIN = false, HOOK = false;
    bf16_t* O; const float* SSQ;
    __device__ __forceinline__ void operator()(const f32x4 (&acc)[2][2][4][2], const Unit& u, int wr, int wc, int fr, int fq) const {
        const int t = u.y >> 3, colt = (u.y & 7) * 256 + wc * 32 + 8 * fq; bf16_t* base = O + (size_t)t * ((size_t)SEQ * DM);
#pragma unroll
        for (int ai = 0; ai < 2; ++ai)
#pragma unroll
            for (int m = 0; m < 4; ++m) { const int row = u.x * 256 + ai * 128 + wr * 64 + m * 16 + fr; const float rs = row_rs(SSQ, row);
#pragma unroll
                for (int bj = 0; bj < 2; ++bj) { const f32x4 v0 = acc[ai][bj][m][0] * rs, v1 = acc[ai][bj][m][1] * rs;
                    u32x4 w; w.x = cvt_pk_bf16(v0.x, v0.y); w.y = cvt_pk_bf16(v0.z, v0.w); w.z = cvt_pk_bf16(v1.x, v1.y); w.w = cvt_pk_bf16(v1.z, v1.w);
                    *(GAS u32x4*)(base + (size_t)row * DM + colt + bj * 128) = w; } }
    }
};

__device__ __forceinline__ void thin_gates(Frame& F, const float* b_i, const float* b_f) {
    const bf16_t* XB = (const bf16_t*)(F.ws + WS_XB); const bf16_t* WIF = (const bf16_t*)(F.ws + WS_WIF); const float* SSQ = (const float*)(F.ws + WS_SSQ);
    float* LOGI = (float*)(F.ws + WS_LOGI); float* LOGF = (float*)(F.ws + WS_LOGF);
    const int r0 = 32 * (int)blockIdx.x, rg = F.wave & 1, kp = F.wave >> 1, l = F.lane;
    f32x4 acc = (f32x4){0.f, 0.f, 0.f, 0.f};
    const bf16_t* ap = XB + (size_t)(r0 + 16 * rg + (l & 15)) * DM + kp * 512 + 8 * (l >> 4);
    const bf16_t* bp = WIF + (size_t)(l & 15) * DM + kp * 512 + 8 * (l >> 4);
#pragma unroll 4
    for (int s = 0; s < 16; ++s) { const bf16x8 a = *(const GAS bf16x8*)(ap + 32 * s), b = *(const GAS bf16x8*)(bp + 32 * s); acc = __builtin_amdgcn_mfma_f32_16x16x32_bf16(a, b, acc, 0, 0, 0); }
    LAS float* part = (LAS float*)F.lds;
#pragma unroll
    for (int r = 0; r < 4; ++r) part[((kp * 2 + rg) * 16 + (l >> 4) * 4 + r) * 16 + (l & 15)] = acc[r];
    LDS_WAIT(); __syncthreads();
    { const int t = F.tid, g2 = t >> 8, row = (t >> 4) & 15, col = t & 15;
      float v = 0.f;
#pragma unroll
      for (int k = 0; k < 4; ++k) v += part[((k * 2 + g2) * 16 + row) * 16 + col];
      const int rowg = r0 + 16 * g2 + row; v *= row_rs(SSQ, rowg);
      const int h = col & 7;
      if (col < 8) LOGI[(size_t)h * SEQ + rowg] = v + b_i[h];
      else { const float x = v + b_f[h]; LOGF[(size_t)h * SEQ + rowg] = fminf(x, 0.f) - log1pf(expf(-fabsf(x))); } }
    __syncthreads();
}

__device__ __forceinline__ void conv_block(Frame& F, const Ptrs& P, int rb) {
    const int sel = F.tid >> 8, c8 = (F.tid & 255) * 8;
    const bf16_t* X = (const bf16_t*)(F.ws + (sel ? WS_MX : WS_RGX)); bf16_t* Y = (bf16_t*)(F.ws + (sel ? WS_XCM : WS_XCRG));
    const float* cw = P.in[sel ? 14 : 7]; const float* cb = P.in[sel ? 15 : 8];
    float w[4][8], b[8];
#pragma unroll
    for (int j = 0; j < 4; ++j) { const f32x4 a = *(const GAS f32x4*)(cw + j * DM + c8), bb = *(const GAS f32x4*)(cw + j * DM + c8 + 4); w[j][0] = a.x; w[j][1] = a.y; w[j][2] = a.z; w[j][3] = a.w; w[j][4] = bb.x; w[j][5] = bb.y; w[j][6] = bb.z; w[j][7] = bb.w; }
    { const f32x4 a = *(const GAS f32x4*)(cb + c8), bb = *(const GAS f32x4*)(cb + c8 + 4); b[0] = a.x; b[1] = a.y; b[2] = a.z; b[3] = a.w; b[4] = bb.x; b[5] = bb.y; b[6] = bb.z; b[7] = bb.w; }
    const int t0 = rb * 32;
    u32x4 h0, h1, h2;
    const u32x4 z = (u32x4){0u, 0u, 0u, 0u};
    h0 = t0 >= 3 ? *(const GAS u32x4*)(X + (size_t)(t0 - 3) * DM + c8) : z;
    h1 = t0 >= 2 ? *(const GAS u32x4*)(X + (size_t)(t0 - 2) * DM + c8) : z;
    h2 = t0 >= 1 ? *(const GAS u32x4*)(X + (size_t)(t0 - 1) * DM + c8) : z;
#pragma unroll 4
    for (int r = 0; r < 32; ++r) {
        const u32x4 cur = *(const GAS u32x4*)(X + (size_t)(t0 + r) * DM + c8);
        float y[8];
#pragma unroll
        for (int q = 0; q < 4; ++q) {
            y[2 * q]     = b[2 * q]     + w[0][2 * q]     * bf_lo(h0[q]) + w[1][2 * q]     * bf_lo(h1[q]) + w[2][2 * q]     * bf_lo(h2[q]) + w[3][2 * q]     * bf_lo(cur[q]);
            y[2 * q + 1] = b[2 * q + 1] + w[0][2 * q + 1] * bf_hi(h0[q]) + w[1][2 * q + 1] * bf_hi(h1[q]) + w[2][2 * q + 1] * bf_hi(h2[q]) + w[3][2 * q + 1] * bf_hi(cur[q]);
        }
        if (sel) {
#pragma unroll
            for (int q = 0; q < 8; ++q) y[q] = y[q] * sigmoidf_(y[q]);
        }
        u32x4 o; o.x = pk2(y[0], y[1]); o.y = pk2(y[2], y[3]); o.z = pk2(y[4], y[5]); o.w = pk2(y[6], y[7]);
        *(GAS u32x4*)(Y + (size_t)(t0 + r) * DM + c8) = o;
        h0 = h1; h1 = h2; h2 = cur;
    }
}

__device__ __forceinline__ float wave_max(float v) {
#pragma unroll
    for (int o = 1; o < 64; o <<= 1) v = fmaxf(v, __shfl_xor(v, o));
    return v;
}
__device__ __forceinline__ void gate_prep(Frame& F, int h, int c) {
    const float* LF = (const float*)(F.ws + WS_LOGF) + (size_t)h * SEQ; const float* LI = (const float*)(F.ws + WS_LOGI) + (size_t)h * SEQ;
    float* TWK = (float*)(F.ws + WS_TWK) + (size_t)h * SEQ; float* TCOL = (float*)(F.ws + WS_TCOL) + (size_t)h * SEQ; float* TROW = (float*)(F.ws + WS_TROW) + (size_t)h * SEQ;
    float* TIW = (float*)(F.ws + WS_TIW) + (size_t)h * SEQ; float* TEMT = (float*)(F.ws + WS_TEMT) + (size_t)h * SEQ; float* TCH = (float*)(F.ws + WS_TCH);
    const int l = F.lane;
    float m_st = 0.f;
    f32x4 lf = *(const GAS f32x4*)(LF + 4 * l), li = *(const GAS f32x4*)(LI + 4 * l);
    for (int cc = 0; cc <= c; ++cc) {
        f32x4 lfn = lf, lin = li;
        if (cc < c) { lfn = *(const GAS f32x4*)(LF + 256 * (cc + 1) + 4 * l); lin = *(const GAS f32x4*)(LI + 256 * (cc + 1) + 4 * l); }
        const float s0 = lf.x, s1 = s0 + lf.y, s2 = s1 + lf.z, s3 = s2 + lf.w;
        float incl = s3;
#pragma unroll
        for (int o = 1; o < 64; o <<= 1) { const float t = __shfl_up(incl, o); if (l >= o) incl += t; }
        const float excl = incl - s3;
        const float b0 = excl + s0, b1 = excl + s1, b2 = excl + s2, b3 = excl + s3;
        const float g = __shfl(incl, 63);
        const float a0 = g - b0 + li.x, a1 = g - b1 + li.y, a2 = g - b2 + li.z, a3 = g - b3 + li.w;
        const float m_loc = wave_max(fmaxf(fmaxf(a0, a1), fmaxf(a2, a3)));
        const float m_new = fmaxf(g + m_st, m_loc);
        if (cc == c) {
            const float c0 = li.x - b0, c1 = li.y - b1, c2 = li.z - b2, c3 = li.w - b3;
            const float p0 = c0, p1 = fmaxf(p0, c1), p2 = fmaxf(p1, c2), p3 = fmaxf(p2, c3);
            float im = p3;
#pragma unroll
            for (int o = 1; o < 64; o <<= 1) { const float t = __shfl_up(im, o); if (l >= o) im = fmaxf(im, t); }
            float ex = __shfl_up(im, 1); if (l == 0) ex = -INFINITY;
            const float q0 = fmaxf(ex, p0), q1 = fmaxf(ex, p1), q2 = fmaxf(ex, p2), q3 = fmaxf(ex, p3);
            const float mp = m_st;
            const float x0 = fmaxf(mp, q0), x1 = fmaxf(mp, q1), x2 = fmaxf(mp, q2), x3 = fmaxf(mp, q3);
            const int o4 = 256 * c + 4 * l;
            *(GAS f32x4*)(TROW + o4) = (f32x4){-x0 * LOG2E, -x1 * LOG2E, -x2 * LOG2E, -x3 * LOG2E};
            *(GAS f32x4*)(TCOL + o4) = (f32x4){c0 * LOG2E, c1 * LOG2E, c2 * LOG2E, c3 * LOG2E};
            *(GAS f32x4*)(TIW + o4) = (f32x4){expf(mp - x0), expf(mp - x1), expf(mp - x2), expf(mp - x3)};
            *(GAS f32x4*)(TEMT + o4) = (f32x4){expf(-(b0 + x0)), expf(-(b1 + x1)), expf(-(b2 + x2)), expf(-(b3 + x3))};
            *(GAS f32x4*)(TWK + o4) = (f32x4){expf(a0 - m_loc), expf(a1 - m_loc), expf(a2 - m_loc), expf(a3 - m_loc)};
            if (l == 0) { TCH[(h * 32 + c) * 2] = expf(g + m_st - m_new); TCH[(h * 32 + c) * 2 + 1] = expf(m_loc - m_new); }
        }
        m_st = m_new; lf = lfn; li = lin;
    }
}

__device__ __forceinline__ u32x4 pack8(const f32x4 v0, const f32x4 v1) { u32x4 w; w.x = cvt_pk_bf16(v0.x, v0.y); w.y = cvt_pk_bf16(v0.z, v0.w); w.z = cvt_pk_bf16(v1.x, v1.y); w.w = cvt_pk_bf16(v1.z, v1.w); return w; }
struct EpiQK {
    static constexpr bool PERM = true, AFTER_DRAIN = false, HOOK = false;
    bf16_t *Q, *K, *QS; const float* TIW;
    __device__ __forceinline__ void operator()(const f32x4 (&acc)[2][2][4][2], const Unit& u, int wr, int wc, int fr, int fq) const {
        const int c = u.x, h = u.y, type = u.z;
        bf16_t* dst = (type == 0 ? Q : K) + (size_t)(256 * c) * DM + 256 * h + wc * 32 + 8 * fq;
#pragma unroll
        for (int ai = 0; ai < 2; ++ai)
#pragma unroll
            for (int m = 0; m < 4; ++m) { const int rl = ai * 128 + wr * 64 + m * 16 + fr;
#pragma unroll
                for (int bj = 0; bj < 2; ++bj) *(GAS u32x4*)(dst + (size_t)rl * DM + bj * 128) = pack8(acc[ai][bj][m][0], acc[ai][bj][m][1]); }
        if (type == 0) {
            bf16_t* d2 = QS + (size_t)(h * 32 + c) * 65536 + wc * 32 + 8 * fq; const float* tiw = TIW + (size_t)h * SEQ + 256 * c;
#pragma unroll
            for (int ai = 0; ai < 2; ++ai)
#pragma unroll
                for (int m = 0; m < 4; ++m) { const int rl = ai * 128 + wr * 64 + m * 16 + fr; const float iw = tiw[rl];
#pragma unroll
                    for (int bj = 0; bj < 2; ++bj) *(GAS u32x4*)(d2 + (size_t)rl * 256 + bj * 128) = pack8(acc[ai][bj][m][0] * iw, acc[ai][bj][m][1] * iw); }
        }
    }
};
struct SchedHC2 {
    int b; const char *A0, *A1, *B0, *B1; size_t a_hc_c, a_hc_h, b_hc_c, b_hc_h;
    __device__ __forceinline__ bool next(int i, Unit& u) const { if (i >= 2) return false; u.x = b >> 3; u.y = b & 7; u.z = i; return true; }
    __device__ __forceinline__ const char* aptr(const Unit& u) const { return (u.z ? A1 : A0) + (size_t)u.x * a_hc_c + (size_t)u.y * a_hc_h; }
    __device__ __forceinline__ const char* bptr(const Unit& u) const { return (u.z ? B1 : B0) + (size_t)u.x * b_hc_c + (size_t)u.y * b_hc_h; }
};
struct EpiKWVT {
    static constexpr bool PERM = true, AFTER_DRAIN = false, HOOK = false;
    bf16_t *KWT, *VT; const float* TWK;
    __device__ __forceinline__ void operator()(const f32x4 (&acc)[2][2][4][2], const Unit& u, int wr, int wc, int fr, int fq) const {
        const int c = u.x, h = u.y, type = u.z;
        f32x4 w0[2], w1[2];
#pragma unroll
        for (int bj = 0; bj < 2; ++bj) { const int cl = bj * 128 + wc * 32 + 8 * fq;
            if (type == 0) { w0[bj] = *(const GAS f32x4*)(TWK + (size_t)h * SEQ + 256 * c + cl); w1[bj] = *(const GAS f32x4*)(TWK + (size_t)h * SEQ + 256 * c + cl + 4); }
            else { w0[bj] = (f32x4){1.f, 1.f, 1.f, 1.f}; w1[bj] = w0[bj]; } }
        bf16_t* dst = (type == 0 ? KWT : VT) + (size_t)(h * 32 + c) * 65536;
#pragma unroll
        for (int ai = 0; ai < 2; ++ai)
#pragma unroll
            for (int m = 0; m < 4; ++m) { const int rl = ai * 128 + wr * 64 + m * 16 + fr;
#pragma unroll
                for (int bj = 0; bj < 2; ++bj) { const int cl = bj * 128 + wc * 32 + 8 * fq;
                    *(GAS u32x4*)(dst + (size_t)rl * 256 + cl) = pack8(acc[ai][bj][m][0] * w0[bj], acc[ai][bj][m][1] * w1[bj]); } }
    }
};
struct SchedHC1 {
    int b; const char *A, *B; size_t a_c, a_h, b_c, b_h;
    __device__ __forceinline__ bool next(int i, Unit& u) const { if (i >= 1) return false; u.x = b >> 3; u.y = b & 7; u.z = 0; return true; }
    __device__ __forceinline__ const char* aptr(const Unit& u) const { return A + (size_t)u.x * a_c + (size_t)u.y * a_h; }
    __device__ __forceinline__ const char* bptr(const Unit& u) const { return B + (size_t)u.x * b_c + (size_t)u.y * b_h; }
};
struct EpiCloc {
    static constexpr bool PERM = true, AFTER_DRAIN = false, HOOK = false;
    bf16_t* O;
    __device__ __forceinline__ void operator()(const f32x4 (&acc)[2][2][4][2], const Unit& u, int wr, int wc, int fr, int fq) const {
        bf16_t* dst = O + (size_t)(u.y * 32 + u.x) * 65536;
#pragma unroll
        for (int ai = 0; ai < 2; ++ai)
#pragma unroll
            for (int m = 0; m < 4; ++m) { const int rl = ai * 128 + wr * 64 + m * 16 + fr;
#pragma unroll
                for (int bj = 0; bj < 2; ++bj) { const int cl = bj * 128 + wc * 32 + 8 * fq; *(GAS u32x4*)(dst + (size_t)rl * 256 + cl) = pack8(acc[ai][bj][m][0], acc[ai][bj][m][1]); } }
    }
};
struct EpiS {
    static constexpr bool PERM = true, AFTER_DRAIN = false, HOOK = false;
    bf16_t* Pm; float* DENP; const float *TROW, *TCOL;
    __device__ __forceinline__ void operator()(const f32x4 (&acc)[2][2][4][2], const Unit& u, int wr, int wc, int fr, int fq) const {
        const int c = u.x, h = u.y;
        float tc[2][8];
#pragma unroll
        for (int bj = 0; bj < 2; ++bj) { const int cl = bj * 128 + wc * 32 + 8 * fq; const f32x4 a = *(const GAS f32x4*)(TCOL + (size_t)h * SEQ + 256 * c + cl), b = *(const GAS f32x4*)(TCOL + (size_t)h * SEQ + 256 * c + cl + 4);
            tc[bj][0] = a.x; tc[bj][1] = a.y; tc[bj][2] = a.z; tc[bj][3] = a.w; tc[bj][4] = b.x; tc[bj][5] = b.y; tc[bj][6] = b.z; tc[bj][7] = b.w; }
        bf16_t* dst = Pm + (size_t)(h * 32 + c) * 65536;
#pragma unroll
        for (int ai = 0; ai < 2; ++ai)
#pragma unroll
            for (int m = 0; m < 4; ++m) { const int rl = ai * 128 + wr * 64 + m * 16 + fr; const float tr = TROW[(size_t)h * SEQ + 256 * c + rl]; float s = 0.f;
#pragma unroll
                for (int bj = 0; bj < 2; ++bj) { const int cl = bj * 128 + wc * 32 + 8 * fq; float p[8];
#pragma unroll
                    for (int n = 0; n < 2; ++n)
#pragma unroll
                        for (int e = 0; e < 4; ++e) { const int j = n * 4 + e; const float v = acc[ai][bj][m][n][e] * fexp2(tr + tc[bj][j]); p[j] = (cl + j <= rl) ? v : 0.f; s += p[j]; }
                    u32x4 w; w.x = cvt_pk_bf16(p[0], p[1]); w.y = cvt_pk_bf16(p[2], p[3]); w.z = cvt_pk_bf16(p[4], p[5]); w.w = cvt_pk_bf16(p[6], p[7]);
                    *(GAS u32x4*)(dst + (size_t)rl * 256 + cl) = w; }
                s += __shfl_xor(s, 16); s += __shfl_xor(s, 32);
                if (fq == 0) DENP[((size_t)h * SEQ + 256 * c + rl) * 4 + wc] = s; }
    }
};

struct SchedRG {
    int L; const char *A, *B;
    __device__ __forceinline__ bool next(int i, Unit& u) const { if (i >= 1) return false; u.x = L >> 4; u.y = L & 15; u.z = 0; return true; }
    __device__ __forceinline__ const char* aptr(const Unit& u) const { return A + ((size_t)u.x * 256 * DM + (size_t)(u.y >> 1) * 256) * 2; }
    __device__ __forceinline__ const char* bptr(const Unit& u) const { return B + (size_t)u.y * 256 * 256 * 2; }
};
__device__ __forceinline__ float gelu_tanh(float x) { return x * sigmoidf_(1.5957691216057308f * (x + 0.044715f * x * x * x)); }
template <bool PASS2> struct EpiRG {
    static constexpr bool PERM = false, AFTER_DRAIN = true, HOOK = false;
    const bf16_t* XC; const float *b_a, *b_x, *lam; float *AGGA, *AGGB; const float* CARRY; const bf16_t* GATE; bf16_t* Y;
    __device__ __forceinline__ void fused(f32x4 (&acc)[2][2][4][2], const Unit& u, int wr, int wc, int fr, int fq, LAS unsigned char* lds, int wid, int lane) const {
        constexpr int LDR = 132;
        LAS float* LA = (LAS float*)lds; LAS float* LB = LA + 128 * LDR;
        LAS float* SEGA = (LAS float*)(lds + LDS_AUX); LAS float* SEGB = SEGA + 512; LAS float* CAR = SEGB + 512;
        const int pm = u.x, ch0 = (u.y >> 1) * 256 + (u.y & 1) * 128, tid = threadIdx.x;
        float sp[2][4], ba[2][4], bx[2][4];
#pragma unroll
        for (int nn = 0; nn < 2; ++nn) { const int cg = ch0 + wc * 32 + nn * 16 + 4 * fq;
            const f32x4 l4 = *(const GAS f32x4*)(lam + cg), a4 = *(const GAS f32x4*)(b_a + cg), x4 = *(const GAS f32x4*)(b_x + cg);
#pragma unroll
            for (int e = 0; e < 4; ++e) { sp[nn][e] = 8.0f * log1pf(expf(-l4[e])); ba[nn][e] = a4[e]; bx[nn][e] = x4[e]; } }
        if (tid < 128) CAR[tid] = PASS2 ? CARRY[(size_t)pm * DM + ch0 + tid] : 0.f;
        float prodA = 1.f;
#pragma unroll 1
        for (int ai = 0; ai < 2; ++ai) {
#pragma unroll
            for (int m = 0; m < 4; ++m) { const int rh = wr * 64 + m * 16 + fr; const int t = pm * 256 + ai * 128 + rh;
#pragma unroll
                for (int nn = 0; nn < 2; ++nn) { const int cl = wc * 32 + nn * 16 + 4 * fq;
                    const u32x2 xr = *(const GAS u32x2*)(XC + (size_t)t * DM + ch0 + cl); const float xc[4] = {bf_lo(xr.x), bf_hi(xr.x), bf_lo(xr.y), bf_hi(xr.y)};
                    const f32x4 rp = ai == 0 ? acc[0][0][m][nn] : acc[1][0][m][nn], ip = ai == 0 ? acc[0][1][m][nn] : acc[1][1][m][nn];
                    f32x4 av, bv;
#pragma unroll
                    for (int e = 0; e < 4; ++e) { const float r = sigmoidf_(rp[e] + ba[nn][e]), ig = sigmoidf_(ip[e] + bx[nn][e]);
                        const float la = -r * sp[nn][e], a = fexp2(la * LOG2E), y2 = 2.0f * la;
                        const float ser = -y2 * (1.0f + y2 * (0.5f + y2 * (0.16666667f + y2 * 0.041666668f)));
                        const float om = y2 > -0.02f ? ser : 1.0f - a * a;
                        av[e] = a; bv[e] = sqrtf(om) * ig * xc[e]; }
                    *(LAS f32x4*)(LA + rh * LDR + cl) = av; *(LAS f32x4*)(LB + rh * LDR + cl) = bv; } }
            LDS_WAIT(); __syncthreads();
            const int cl = tid & 127, seg = tid >> 7;
            { float A = 1.f, Bv = 0.f;
#pragma unroll 8
              for (int r = 0; r < 32; ++r) { const float a = LA[(seg * 32 + r) * LDR + cl], bt = LB[(seg * 32 + r) * LDR + cl]; Bv = a * Bv + bt; A *= a; }
              SEGA[seg * 128 + cl] = A; SEGB[seg * 128 + cl] = Bv; }
            LDS_WAIT(); __syncthreads();
            { float hin = CAR[ai * 128 + cl];
              for (int s2 = 0; s2 < seg; ++s2) hin = SEGA[s2 * 128 + cl] * hin + SEGB[s2 * 128 + cl];
              if (PASS2) { float hh = hin;
#pragma unroll 8
                  for (int r = 0; r < 32; ++r) { hh = LA[(seg * 32 + r) * LDR + cl] * hh + LB[(seg * 32 + r) * LDR + cl]; LB[(seg * 32 + r) * LDR + cl] = hh; } }
              if (seg == 3) { CAR[(ai + 1) * 128 + cl] = SEGA[3 * 128 + cl] * hin + SEGB[3 * 128 + cl];
                  prodA *= SEGA[cl] * SEGA[128 + cl] * SEGA[256 + cl] * SEGA[384 + cl]; } }
            LDS_WAIT(); __syncthreads();
            if (PASS2) {
#pragma unroll
                for (int m = 0; m < 4; ++m) { const int rh = wr * 64 + m * 16 + fr; const int t = pm * 256 + ai * 128 + rh;
#pragma unroll
                    for (int nn = 0; nn < 2; ++nn) { const int c2 = wc * 32 + nn * 16 + 4 * fq;
                        const f32x4 hv = *(const LAS f32x4*)(LB + rh * LDR + c2);
                        const u32x2 gr = *(const GAS u32x2*)(GATE + (size_t)t * DM + ch0 + c2);
                        u32x2 o; o.x = cvt_pk_bf16(hv.x * gelu_tanh(bf_lo(gr.x)), hv.y * gelu_tanh(bf_hi(gr.x))); o.y = cvt_pk_bf16(hv.z * gelu_tanh(bf_lo(gr.y)), hv.w * gelu_tanh(bf_hi(gr.y)));
                        *(GAS u32x2*)(Y + (size_t)t * DM + ch0 + c2) = o; } }
                LDS_WAIT(); __syncthreads();
            }
        }
        if (!PASS2) { const int cl = tid & 127; if ((tid >> 7) == 3) { AGGA[(size_t)pm * DM + ch0 + cl] = prodA; AGGB[(size_t)pm * DM + ch0 + cl] = CAR[2 * 128 + cl]; } }
        __syncthreads();
    }
};

struct EpiNum {
    static constexpr bool PERM = true, AFTER_DRAIN = true, HOOK = false;
    const bf16_t* QS; const float *NP, *DENP, *TEMT; const float *mnorm, *mskip; const bf16_t *XCM, *MO; bf16_t* YM;
    __device__ __forceinline__ void fused(f32x4 (&acc)[2][2][4][2], const Unit& u, int wr, int wc, int fr, int fq, LAS unsigned char* lds, int wid, int lane) const {
        const int c = u.x, h = u.y, tid = threadIdx.x;
        LAS float* NPv = (LAS float*)lds; LAS float* RDEN = NPv + 256; LAS f32x2* STAT = (LAS f32x2*)(lds + 2048); LAS f32x2* MR = (LAS f32x2*)(lds + 2048 + 8192);
        if (tid < 256) NPv[tid] = NP[(size_t)(h * 32 + c) * 256 + tid];
        LDS_WAIT(); __syncthreads();
        if (tid < 256) { const bf16_t* qrow = QS + ((size_t)(h * 32 + c) * 256 + tid) * 256; float d = 0.f;
#pragma unroll 4
            for (int k8 = 0; k8 < 32; ++k8) { const u32x4 qv = *(const GAS u32x4*)(qrow + 8 * k8); const LAS float* nv = NPv + 8 * k8;
                d += bf_lo(qv.x) * nv[0] + bf_hi(qv.x) * nv[1] + bf_lo(qv.y) * nv[2] + bf_hi(qv.y) * nv[3] + bf_lo(qv.z) * nv[4] + bf_hi(qv.z) * nv[5] + bf_lo(qv.w) * nv[6] + bf_hi(qv.w) * nv[7]; }
            const size_t tg = (size_t)h * SEQ + 256 * c + tid; const f32x4 dp = *(const GAS f32x4*)(DENP + tg * 4);
            const float den = d + ((dp.x + dp.y) + (dp.z + dp.w));
            RDEN[tid] = 1.0f / fmaxf(fabsf(den), TEMT[tg]); }
        LDS_WAIT(); __syncthreads();
#pragma unroll
        for (int ai = 0; ai < 2; ++ai)
#pragma unroll
            for (int m = 0; m < 4; ++m) { const int rl = ai * 128 + wr * 64 + m * 16 + fr; const float rd = RDEN[rl]; float s = 0.f, q = 0.f;
#pragma unroll
                for (int bj = 0; bj < 2; ++bj)
#pragma unroll
                    for (int n = 0; n < 2; ++n) { f32x4 v = acc[ai][bj][m][n] * rd; acc[ai][bj][m][n] = v; s += (v.x + v.y) + (v.z + v.w); q += (v.x * v.x + v.y * v.y) + (v.z * v.z + v.w * v.w); }
                s += __shfl_xor(s, 16); s += __shfl_xor(s, 32); q += __shfl_xor(q, 16); q += __shfl_xor(q, 32);
                if (fq == 0) STAT[rl * 4 + wc] = (f32x2){s, q}; }
        LDS_WAIT(); __syncthreads();
        if (tid < 256) { const f32x2 a = STAT[tid * 4], b = STAT[tid * 4 + 1], c2 = STAT[tid * 4 + 2], d2 = STAT[tid * 4 + 3];
            const float mu = ((a.x + b.x) + (c2.x + d2.x)) * (1.0f / 256.0f); const float var = fmaxf(((a.y + b.y) + (c2.y + d2.y)) * (1.0f / 256.0f) - mu * mu, 0.f);
            MR[tid] = (f32x2){mu, 1.0f / sqrtf(var + EPS)}; }
        LDS_WAIT(); __syncthreads();
#pragma unroll
        for (int bj = 0; bj < 2; ++bj) { const int cl = bj * 128 + wc * 32 + 8 * fq, cg = 256 * h + cl;
            const f32x4 g0 = *(const GAS f32x4*)(mnorm + cg), g1 = *(const GAS f32x4*)(mnorm + cg + 4), k0 = *(const GAS f32x4*)(mskip + cg), k1 = *(const GAS f32x4*)(mskip + cg + 4);
#pragma unroll
            for (int ai = 0; ai < 2; ++ai)
#pragma unroll
                for (int m = 0; m < 4; ++m) { const int rl = ai * 128 + wr * 64 + m * 16 + fr; const size_t off = (size_t)(256 * c + rl) * DM + cg; const f32x2 mr = MR[rl];
                    const u32x4 xr = *(const GAS u32x4*)(XCM + off), orr = *(const GAS u32x4*)(MO + off);
                    const f32x4 v0 = acc[ai][bj][m][0], v1 = acc[ai][bj][m][1];
                    float y[8];
                    y[0] = ((v0.x - mr.x) * mr.y * g0.x + k0.x * bf_lo(xr.x)) * sigmoidf_(bf_lo(orr.x)); y[1] = ((v0.y - mr.x) * mr.y * g0.y + k0.y * bf_hi(xr.x)) * sigmoidf_(bf_hi(orr.x));
                    y[2] = ((v0.z - mr.x) * mr.y * g0.z + k0.z * bf_lo(xr.y)) * sigmoidf_(bf_lo(orr.y)); y[3] = ((v0.w - mr.x) * mr.y * g0.w + k0.w * bf_hi(xr.y)) * sigmoidf_(bf_hi(orr.y));
                    y[4] = ((v1.x - mr.x) * mr.y * g1.x + k1.x * bf_lo(xr.z)) * sigmoidf_(bf_lo(orr.z)); y[5] = ((v1.y - mr.x) * mr.y * g1.y + k1.y * bf_hi(xr.z)) * sigmoidf_(bf_hi(orr.z));
                    y[6] = ((v1.z - mr.x) * mr.y * g1.z + k1.z * bf_lo(xr.w)) * sigmoidf_(bf_lo(orr.w)); y[7] = ((v1.w - mr.x) * mr.y * g1.w + k1.w * bf_hi(xr.w)) * sigmoidf_(bf_hi(orr.w));
                    u32x4 w; w.x = cvt_pk_bf16(y[0], y[1]); w.y = cvt_pk_bf16(y[2], y[3]); w.z = cvt_pk_bf16(y[4], y[5]); w.w = cvt_pk_bf16(y[6], y[7]);
                    *(GAS u32x4*)(YM + off) = w; } }
        __syncthreads();
    }
};

struct SchedMerge {
    GridOrder go; const char *A0, *A1, *B0, *B1; size_t a_tile, b_tile;
    __device__ __forceinline__ bool next(int i, Unit& u) const { if (i >= 2) return false; int pm, pn; if (!go.tile(0, pm, pn)) return false; u.x = pm; u.y = pn; u.z = i; return true; }
    __device__ __forceinline__ const char* aptr(const Unit& u) const { return (u.z ? A1 : A0) + (size_t)u.x * a_tile; }
    __device__ __forceinline__ const char* bptr(const Unit& u) const { return (u.z ? B1 : B0) + (size_t)u.y * b_tile; }
};
struct EpiMerge {
    static constexpr bool PERM = true, AFTER_DRAIN = false, HOOK = false;
    const bf16_t *GRG, *GM; float* T; bf16_t* O;
    __device__ __forceinline__ void operator()(const f32x4 (&acc)[2][2][4][2], const Unit& u, int wr, int wc, int fr, int fq) const {
        const bf16_t* G = u.z ? GM : GRG;
#pragma unroll
        for (int ai = 0; ai < 2; ++ai)
#pragma unroll
            for (int m = 0; m < 4; ++m) { const int row = u.x * 256 + ai * 128 + wr * 64 + m * 16 + fr;
#pragma unroll
                for (int bj = 0; bj < 2; ++bj) { const size_t off = (size_t)row * DM + u.y * 256 + bj * 128 + wc * 32 + 8 * fq;
                    const u32x4 b = *(const GAS u32x4*)(G + off);
                    const f32x4 s0 = (f32x4){sigmoidf_(bf_lo(b.x)), sigmoidf_(bf_hi(b.x)), sigmoidf_(bf_lo(b.y)), sigmoidf_(bf_hi(b.y))}, s1 = (f32x4){sigmoidf_(bf_lo(b.z)), sigmoidf_(bf_hi(b.z)), sigmoidf_(bf_lo(b.w)), sigmoidf_(bf_hi(b.w))};
                    const f32x4 v0 = acc[ai][bj][m][0] * s0, v1 = acc[ai][bj][m][1] * s1;
                    if (u.z == 0) { *(GAS f32x4*)(T + off) = v0; *(GAS f32x4*)(T + off + 4) = v1; }
                    else { const f32x4 t0 = *(const GAS f32x4*)(T + off), t1 = *(const GAS f32x4*)(T + off + 4); *(GAS u32x4*)(O + off) = pack8(t0 + v0, t1 + v1); } } }
    }
};

__device__ __forceinline__ void state_scan(Frame& F) {
    const bf16_t* CLOC = (const bf16_t*)(F.ws + WS_CLOC); bf16_t* CP = (bf16_t*)(F.ws + WS_CP); const float* TCH = (const float*)(F.ws + WS_TCH);
    const int g = (int)blockIdx.x * 512 + F.tid, h = (int)blockIdx.x >> 5;
    const size_t e0 = (size_t)(g & 16383) * 4;
    float C0 = 0.f, C1 = 0.f, C2 = 0.f, C3 = 0.f;
#pragma unroll 4
    for (int c = 0; c < 32; ++c) { const size_t off = (size_t)(h * 32 + c) * 65536 + e0;
        const u32x2 v = *(const GAS u32x2*)(CLOC + off);
        u32x2 o; o.x = pk2(C0, C1); o.y = pk2(C2, C3); *(GAS u32x2*)(CP + off) = o;
        const float so = TCH[(h * 32 + c) * 2], sl = TCH[(h * 32 + c) * 2 + 1];
        C0 = so * C0 + sl * bf_lo(v.x); C1 = so * C1 + sl * bf_hi(v.x); C2 = so * C2 + sl * bf_lo(v.y); C3 = so * C3 + sl * bf_hi(v.y); }
}
__device__ __forceinline__ void n_scan(Frame& F) {
    const bf16_t* KWT = (const bf16_t*)(F.ws + WS_KWT); float* NP = (float*)(F.ws + WS_NP); const float* TCH = (const float*)(F.ws + WS_TCH);
    const int gw = (int)blockIdx.x * 8 + F.wave, h = gw >> 8, kd = gw & 255;
    float n = 0.f;
#pragma unroll 4
    for (int c = 0; c < 32; ++c) { const u32x2 v = *(const GAS u32x2*)(KWT + ((size_t)(h * 32 + c) * 256 + kd) * 256 + 4 * F.lane);
        const float s = wave_sum((bf_lo(v.x) + bf_hi(v.x)) + (bf_lo(v.y) + bf_hi(v.y)));
        if (F.lane == 0) NP[(size_t)(h * 32 + c) * 256 + kd] = n;
        n = TCH[(h * 32 + c) * 2] * n + TCH[(h * 32 + c) * 2 + 1] * s; }
}
__device__ __forceinline__ void rg_carry(Frame& F) {
    const int g = (int)blockIdx.x * 512 + F.tid; if (g >= DM) return;
    const float* AGGA = (const float*)(F.ws + WS_AGGA); const float* AGGB = (const float*)(F.ws + WS_AGGB); float* CARRY = (float*)(F.ws + WS_CARRY);
    float hh = 0.f;
#pragma unroll 8
    for (int pm = 0; pm < 32; ++pm) { CARRY[(size_t)pm * DM + g] = hh; hh = AGGA[(size_t)pm * DM + g] * hh + AGGB[(size_t)pm * DM + g]; }
}

struct Args { float* out; unsigned char* ws; int ph_lo, ph_hi; int flags, pad; Ptrs p; };


__global__ void __launch_bounds__(512, 2) mega_fwd(Args args) {
    __shared__ __attribute__((aligned(16))) unsigned char lds_raw[LDS_BYTES];
    Frame F;
    F.lds = (LAS unsigned char*)lds_raw;
    F.tid = threadIdx.x; F.lane = F.tid & 63; F.wave = __builtin_amdgcn_readfirstlane(F.tid >> 6);
    F.G = gridDim.x; { const int bx = blockIdx.x; F.vcu = (F.G % 8 == 0) ? (bx % 8) * (F.G / 8) + bx / 8 : bx; }
    F.ws = args.ws; F.H = args.out;
    const Ptrs& P = args.p;
    if (args.flags) { const float c = 100.0f * (float)args.flags; for (size_t i = (size_t)blockIdx.x * 512 + threadIdx.x; i < (size_t)SEQ * DM; i += (size_t)gridDim.x * 512) args.out[i] = c; return; }
    volatile LAS unsigned* lctl = (volatile LAS unsigned*)(F.lds + LDS_CTL);
    if (F.tid < 64) lctl[F.tid] = 0u;
    __syncthreads();
    XcdBarrier bar; bar.bar = (unsigned*)(F.ws + WS_CTL); bar.x = 0; bar.st = lctl + 8;
    bar = xcd_barrier_post((unsigned*)(F.ws + WS_CTL), lctl + 8);
    const int lo = args.ph_lo, hi = args.ph_hi;
#ifndef ONLY_PHASE
#define ONLY_PHASE -1
#endif
#define IN(k) ((ONLY_PHASE < 0 || ONLY_PHASE == (k)) && lo <= (k) && (k) < hi)
#define PHASE_BEGIN() do { int t_ = threadIdx.x; asm volatile("" : "+v"(t_)); F.tid = t_; F.lane = t_ & 63; } while (0)
#define SEAM(k) do { if (lo <= (k) && (k) + 1 < hi) xcd_barrier(bar); } while (0)

    if (IN(0)) { PHASE_BEGIN(); convert_weights(F, P, 0); p0_wif(F, P.in[6], P.in[5]); p0_rows(F, P.in[0]); }
    SEAM(0);
    if (IN(1)) { PHASE_BEGIN();
        SchedGrid S; S.go.init(SEQ / 256, FF / 128, F.G, (int)blockIdx.x); S.A = (const char*)(F.ws + WS_XB); S.B = (const char*)(F.ws + WS_W1GU); S.a_tile = (size_t)256 * DM * 2; S.b_tile = (size_t)256 * DM * 2;
        EpiSwiglu E{(bf16_t*)(F.ws + WS_HID1), (const float*)(F.ws + WS_SSQ)};
        pg8::gemm_phase<EpiSwiglu, SchedGrid, true>(F.lds, DM * 2, DM * 2, pg8::kseg_plain(DM), S, E);
    }
    SEAM(1);
    if (IN(2)) { PHASE_BEGIN();
        SchedGrid S; S.go.init(SEQ / 256, DM / 256, F.G, (int)blockIdx.x); S.A = (const char*)(F.ws + WS_HID1); S.B = (const char*)(F.ws + WS_W1D); S.a_tile = (size_t)256 * FF * 2; S.b_tile = (size_t)256 * FF * 2;
        EpiResid E{P.in[0], F.H, (bf16_t*)(F.ws + WS_XB), (float*)(F.ws + WS_SSQ), 0.5f};
        pg8::gemm_phase<EpiResid, SchedGrid, false>(F.lds, FF * 2, FF * 2, pg8::kseg_plain(FF), S, E);
    }
    SEAM(2);
    if (IN(3)) { PHASE_BEGIN();
        SchedGrid S; S.go.init(SEQ / 256, 12288 / 256, F.G, (int)blockIdx.x); S.A = (const char*)(F.ws + WS_XB); S.B = (const char*)(F.ws + WS_WIN); S.a_tile = (size_t)256 * DM * 2; S.b_tile = (size_t)256 * DM * 2;
        EpiProj E{(bf16_t*)(F.ws + WS_PROJ), (const float*)(F.ws + WS_SSQ)};
        pg8::gemm_phase<EpiProj, SchedGrid, true>(F.lds, DM * 2, DM * 2, pg8::kseg_plain(DM), S, E);
        thin_gates(F, P.in[19], P.in[20]);
    }
    SEAM(3);
    if (IN(4)) { PHASE_BEGIN();
        conv_block(F, P, (int)blockIdx.x);
        if (F.wave == 0) gate_prep(F, (int)blockIdx.x & 7, (int)blockIdx.x >> 3);
    }
    SEAM(4);
    if (IN(6)) { PHASE_BEGIN();
        const int b = (int)blockIdx.x;
#ifndef SUB
#define SUB 0
#endif
        if (SUB == 0 || SUB == 1) { SchedHC2 S; S.b = b; S.A0 = S.A1 = (const char*)(F.ws + WS_XCM); S.B0 = (const char*)(F.ws + WS_WQ); S.B1 = (const char*)(F.ws + WS_WK);
          S.a_hc_c = (size_t)256 * DM * 2; S.a_hc_h = 512; S.b_hc_c = 0; S.b_hc_h = 131072;
          EpiQK E{(bf16_t*)(F.ws + WS_Q), (bf16_t*)(F.ws + WS_K), (bf16_t*)(F.ws + WS_QS), (const float*)(F.ws + WS_TIW)};
          pg8::gemm_phase<EpiQK, SchedHC2, true>(F.lds, DM * 2, 512, pg8::kseg_plain(256), S, E); }
        if (SUB == 0 || SUB == 2) { SchedHC2 S; S.b = b; S.A0 = (const char*)(F.ws + WS_WK); S.A1 = (const char*)(F.ws + WS_WV); S.B0 = (const char*)(F.ws + WS_XCM); S.B1 = (const char*)(F.ws + WS_MX);
          S.a_hc_c = 0; S.a_hc_h = 131072; S.b_hc_c = (size_t)256 * DM * 2; S.b_hc_h = 512;
          EpiKWVT E{(bf16_t*)(F.ws + WS_KWT), (bf16_t*)(F.ws + WS_VT), (const float*)(F.ws + WS_TWK)};
          pg8::gemm_phase<EpiKWVT, SchedHC2, true>(F.lds, 512, DM * 2, pg8::kseg_plain(256), S, E); }
#pragma unroll 1
        for (int r = 0; r < ((SUB == 0 || SUB == 3) ? 2 : 0); ++r) { SchedRG S; S.L = 2 * b + r; S.A = (const char*)(F.ws + WS_XCRG); S.B = (const char*)(F.ws + WS_WRG);
          EpiRG<false> E{(const bf16_t*)(F.ws + WS_XCRG), P.in[10], P.in[12], P.in[13], (float*)(F.ws + WS_AGGA), (float*)(F.ws + WS_AGGB), nullptr, nullptr, nullptr};
          pg8::gemm_phase<EpiRG<false>, SchedRG, false>(F.lds, DM * 2, 512, pg8::kseg_plain(256), S, E); }
    }
    SEAM(6);
    if (IN(7)) { PHASE_BEGIN();
        const int b = (int)blockIdx.x;
        rg_carry(F);
        if (SUB == 0 || SUB == 1) { SchedHC1 S; S.b = b; S.A = (const char*)(F.ws + WS_VT); S.B = (const char*)(F.ws + WS_KWT); S.a_c = 131072; S.a_h = (size_t)32 * 131072; S.b_c = 131072; S.b_h = (size_t)32 * 131072;
          EpiCloc E{(bf16_t*)(F.ws + WS_CLOC)};
          pg8::gemm_phase<EpiCloc, SchedHC1, false>(F.lds, 512, 512, pg8::kseg_plain(256), S, E); }
        if (SUB == 0 || SUB == 2) { SchedHC1 S; S.b = b; S.A = (const char*)(F.ws + WS_Q); S.B = (const char*)(F.ws + WS_K); S.a_c = (size_t)256 * DM * 2; S.a_h = 512; S.b_c = (size_t)256 * DM * 2; S.b_h = 512;
          EpiS E{(bf16_t*)(F.ws + WS_P), (float*)(F.ws + WS_DENP), (const float*)(F.ws + WS_TROW), (const float*)(F.ws + WS_TCOL)};
          pg8::gemm_phase<EpiS, SchedHC1, false>(F.lds, DM * 2, DM * 2, pg8::kseg_plain(256), S, E); }
    }
    SEAM(7);
    if (IN(8)) { PHASE_BEGIN();
        const int b = (int)blockIdx.x;
        state_scan(F); n_scan(F);
#pragma unroll 1
        for (int r = 0; r < 2; ++r) { SchedRG S; S.L = 2 * b + r; S.A = (const char*)(F.ws + WS_XCRG); S.B = (const char*)(F.ws + WS_WRG);
          EpiRG<true> E{(const bf16_t*)(F.ws + WS_XCRG), P.in[10], P.in[12], P.in[13], nullptr, nullptr, (const float*)(F.ws + WS_CARRY), (const bf16_t*)(F.ws + WS_RGG), (bf16_t*)(F.ws + WS_YRG)};
          pg8::gemm_phase<EpiRG<true>, SchedRG, false>(F.lds, DM * 2, 512, pg8::kseg_plain(256), S, E); }
    }
    SEAM(8);
    if (IN(9)) { PHASE_BEGIN();
        const int b = (int)blockIdx.x;
        convert_weights(F, P, 1);
        __syncthreads();
        { SchedHC1 S; S.b = b; S.A = (const char*)(F.ws + WS_P); S.B = (const char*)(F.ws + WS_VT); S.a_c = 131072; S.a_h = (size_t)32 * 131072; S.b_c = 131072; S.b_h = (size_t)32 * 131072;
          KSeg ks; ks.nt = 8; ks.sh = 2; ks.mask = 3u; ks.segA = (long)WS_QS - (long)WS_P; ks.segB = (long)WS_CP - (long)WS_VT;
          EpiNum E{(const bf16_t*)(F.ws + WS_QS), (const float*)(F.ws + WS_NP), (const float*)(F.ws + WS_DENP), (const float*)(F.ws + WS_TEMT), P.in[21], P.in[22], (const bf16_t*)(F.ws + WS_XCM), (const bf16_t*)(F.ws + WS_MO), (bf16_t*)(F.ws + WS_YM)};
          pg8::gemm_phase<EpiNum, SchedHC1, false>(F.lds, 512, 512, ks, S, E); }
    }
    SEAM(9);
    if (IN(10)) { PHASE_BEGIN();
        SchedMerge S; S.go.init(SEQ / 256, DM / 256, F.G, (int)blockIdx.x); S.A0 = (const char*)(F.ws + WS_YRG); S.A1 = (const char*)(F.ws + WS_YM); S.B0 = (const char*)(F.ws + WS_WPRG); S.B1 = (const char*)(F.ws + WS_WPM);
        S.a_tile = (size_t)256 * DM * 2; S.b_tile = (size_t)256 * DM * 2;
        EpiMerge E{(const bf16_t*)(F.ws + WS_GRG), (const bf16_t*)(F.ws + WS_GM), (float*)(F.ws + WS_TMRG), (bf16_t*)(F.ws + WS_MERGED)};
        pg8::gemm_phase<EpiMerge, SchedMerge, false>(F.lds, DM * 2, DM * 2, pg8::kseg_plain(DM), S, E);
    }
    SEAM(10);
    if (IN(11)) { PHASE_BEGIN();
        SchedGrid S; S.go.init(SEQ / 256, DM / 256, F.G, (int)blockIdx.x); S.A = (const char*)(F.ws + WS_MERGED); S.B = (const char*)(F.ws + WS_WOUT); S.a_tile = (size_t)256 * DM * 2; S.b_tile = (size_t)256 * DM * 2;
        EpiResid E{F.H, F.H, (bf16_t*)(F.ws + WS_XB), (float*)(F.ws + WS_SSQ), 1.0f};
        pg8::gemm_phase<EpiResid, SchedGrid, false>(F.lds, DM * 2, DM * 2, pg8::kseg_plain(DM), S, E);
    }
    SEAM(11);
    if (IN(12)) { PHASE_BEGIN();
        SchedGrid S; S.go.init(SEQ / 256, FF / 128, F.G, (int)blockIdx.x); S.A = (const char*)(F.ws + WS_XB); S.B = (const char*)(F.ws + WS_W2GU); S.a_tile = (size_t)256 * DM * 2; S.b_tile = (size_t)256 * DM * 2;
        EpiSwiglu E{(bf16_t*)(F.ws + WS_HID2), (const float*)(F.ws + WS_SSQ)};
        pg8::gemm_phase<EpiSwiglu, SchedGrid, true>(F.lds, DM * 2, DM * 2, pg8::kseg_plain(DM), S, E);
    }
    SEAM(12);
    if (IN(13)) { PHASE_BEGIN();
        SchedGrid S; S.go.init(SEQ / 256, DM / 256, F.G, (int)blockIdx.x); S.A = (const char*)(F.ws + WS_HID2); S.B = (const char*)(F.ws + WS_W2D); S.a_tile = (size_t)256 * FF * 2; S.b_tile = (size_t)256 * FF * 2;
        EpiResid E{F.H, F.H, nullptr, (float*)(F.ws + WS_SSQ), 0.5f};
        pg8::gemm_phase<EpiResid, SchedGrid, false>(F.lds, FF * 2, FF * 2, pg8::kseg_plain(FF), S, E);
    }
    SEAM(13);
    if (IN(14)) { PHASE_BEGIN(); final_norm(F, P.in[30]); }
#undef IN
#undef SEAM
}

extern "C" void kernel_launch(void* const* d_in, const int* in_sizes, int n_in, void* d_out, int out_size, void* d_ws, size_t ws_size, hipStream_t stream) {
    int flags = 0;
    if (n_in != 31 || out_size != SEQ * DM) flags |= 1;
    if (ws_size < WS_END) flags |= 2;
    { int per_cu = 0; if (hipOccupancyMaxActiveBlocksPerMultiprocessor(&per_cu, (const void*)mega_fwd, 512, 0) != hipSuccess || per_cu < 1) { flags |= 4; (void)hipGetLastError(); } }
    { int dev = 0, cus = 0; if (hipGetDevice(&dev) != hipSuccess || hipDeviceGetAttribute(&cus, hipDeviceAttributeMultiprocessorCount, dev) != hipSuccess || cus != 256) { flags |= 8; (void)hipGetLastError(); } }
    const int grid = 256;
    (void)hipMemsetAsync((char*)d_ws + WS_CTL, 0, CTL_BYTES, stream);
    Args a{};
    for (int i = 0; i < 31; ++i) a.p.in[i] = (const float*)d_in[i];
    a.out = (float*)d_out; a.ws = (unsigned char*)d_ws; a.ph_lo = 0; a.ph_hi = 100; a.flags = flags;
    hipLaunchKernelGGL(mega_fwd, dim3(grid), dim3(512), 0, stream, a);
}
```

```cpp
#include <hip/hip_runtime.h>
#include <cstdio>
#include <cstdint>

#define LAS __attribute__((address_space(3)))
#define GAS __attribute__((address_space(1)))
typedef unsigned short bf16_t;
typedef short bf16x8 __attribute__((ext_vector_type(8)));
typedef float f32x4 __attribute__((ext_vector_type(4)));
typedef float f32x2 __attribute__((ext_vector_type(2)));
typedef unsigned u32x4 __attribute__((ext_vector_type(4)));
typedef unsigned u32x2 __attribute__((ext_vector_type(2)));

constexpr int SEQ = 8192, DM = 2048, FF = 5632, NH = 8, HD = 256, NCH = SEQ / 256;
constexpr int DIN = 12304;
constexpr float EPS = 1e-6f;
constexpr float LOG2E = 1.4426950408889634f;

constexpr size_t MiB = 1u << 20;
constexpr size_t SLOT = 32 * MiB;
#define WS_S(i) ((size_t)(i) * SLOT)
constexpr size_t WS_W1GU = 0, WS_W1D = 44 * MiB, WS_WIN = 66 * MiB;
constexpr size_t WS_XB = WS_S(4);
constexpr size_t WS_HID1 = WS_S(5);
constexpr size_t WS_PROJ = WS_S(5);
constexpr size_t WS_RGX = WS_S(5), WS_RGG = WS_S(6), WS_MX = WS_S(7), WS_MO = WS_S(8), WS_GRG = WS_S(9), WS_GM = WS_S(10);
constexpr size_t WS_XCRG = WS_S(0), WS_XCM = WS_S(1);
constexpr size_t WS_Q = WS_S(2), WS_K = WS_S(3), WS_QS = WS_S(4), WS_VT = WS_S(5), WS_KWT = WS_S(11);
constexpr size_t WS_P = WS_S(7), WS_CLOC = WS_S(12);
constexpr size_t WS_CP = WS_S(2), WS_YRG = WS_S(3);
constexpr size_t WS_W2GU = WS_S(11), WS_W2D = WS_S(13), WS_WPRG = WS_S(13) + 22 * MiB;
constexpr size_t WS_YM = WS_S(6), WS_MERGED = WS_S(0);
constexpr size_t WS_HID2 = WS_S(0);
constexpr size_t WS_TMRG = WS_S(1);
constexpr size_t WS_SMALL = WS_S(14);
constexpr size_t WS_CTL = WS_SMALL;
constexpr size_t CTL_BYTES = 64 * 1024;
constexpr size_t WS_WIF = WS_SMALL + 64 * 1024;
constexpr size_t WS_WRG = WS_SMALL + 1 * MiB;
constexpr size_t WS_WQ = WS_SMALL + 3 * MiB, WS_WK = WS_SMALL + 4 * MiB, WS_WV = WS_SMALL + 5 * MiB;
constexpr size_t WS_SSQ = WS_SMALL + 6 * MiB;
constexpr size_t WS_LOGI = WS_SSQ + 256 * 1024, WS_LOGF = WS_LOGI + 256 * 1024;
constexpr size_t WS_TWK = WS_LOGF + 256 * 1024, WS_TCOL = WS_TWK + 256 * 1024, WS_TROW = WS_TCOL + 256 * 1024, WS_TIW = WS_TROW + 256 * 1024, WS_TEMT = WS_TIW + 256 * 1024;
constexpr size_t WS_TCH = WS_TEMT + 256 * 1024;
constexpr size_t WS_AGGA = WS_TCH + 64 * 1024, WS_AGGB = WS_AGGA + 256 * 1024;
constexpr size_t WS_DENP = WS_AGGB + 256 * 1024;
constexpr size_t WS_NP = WS_DENP + 1 * MiB;
constexpr size_t WS_CARRY = WS_NP + 256 * 1024;
constexpr size_t WS_WPM = WS_CARRY + 256 * 1024, WS_WOUT = WS_WPM + 8 * MiB;
constexpr size_t WS_END = WS_WOUT + 8 * MiB;

#ifndef LDS_TEST
#define LDS_TEST 0
#endif
#ifndef NO_BARRIER
#define NO_BARRIER 0
#endif
#ifndef SKEL_XONLY
#define SKEL_XONLY 0
#endif
constexpr int RING_BYTES = 131072;
constexpr int LDS_AUX = 135168;
constexpr int LDS_CTL = LDS_TEST ? 16384 : 143360;
constexpr int LDS_BYTES = LDS_TEST ? 32768 : 147456;

#define LDS_WAIT() asm volatile("s_waitcnt lgkmcnt(0)" ::: "memory")
#define VM_WAIT() asm volatile("s_waitcnt vmcnt(0)" ::: "memory")

__device__ __forceinline__ unsigned f2bf(float f) { unsigned u = __builtin_bit_cast(unsigned, f); return (u + 0x7fffu + ((u >> 16) & 1u)) >> 16; }
__device__ __forceinline__ unsigned pk2(float lo, float hi) { return f2bf(lo) | (f2bf(hi) << 16); }
__device__ __forceinline__ float bf_lo(unsigned u) { return __builtin_bit_cast(float, u << 16); }
__device__ __forceinline__ float bf_hi(unsigned u) { return __builtin_bit_cast(float, u & 0xffff0000u); }
__device__ __forceinline__ unsigned cvt_pk_bf16(float lo, float hi) { unsigned r; asm volatile("v_cvt_pk_bf16_f32 %0, %1, %2" : "=v"(r) : "v"(lo), "v"(hi)); return r; }
__device__ __forceinline__ float fexp2(float x) { return __builtin_amdgcn_exp2f(x); }
__device__ __forceinline__ float frcp(float x) { return __builtin_amdgcn_rcpf(x); }
__device__ __forceinline__ float sigmoidf_(float x) { return frcp(1.0f + fexp2(-x * LOG2E)); }
__device__ __forceinline__ float wave_sum(float v) {
#pragma unroll
    for (int o = 1; o < 64; o <<= 1) v += __shfl_xor(v, o);
    return v;
}

namespace pg8 {
constexpr int BM = 256, BK = 64, HALF = 128, HTB = HALF * BK * 2, STAGE_BYTES = 8 * HTB, NXCD = 8, WGM = 8;
__host__ __device__ __forceinline__ int lds_byte(int r, int c) { const int st = (r >> 4) * 2 + (c >> 5), rr = r & 15, cc = c & 31, ob = rr * 64 + cc * 2; return st * 1024 + (ob ^ (((ob >> 9) & 1) << 5)); }
__host__ __device__ __forceinline__ void stage_rc(int b, int& R, int& C) { const int st = b / 1024, sb = b % 1024, swz = sb ^ (((sb >> 9) & 1) << 5); R = (st >> 1) * 16 + swz / 64; C = (st & 1) * 32 + (swz % 64) / 2; }
__host__ __device__ __forceinline__ int perm32(int rho) { const int n = rho >> 4, i = rho & 15; return 8 * (i >> 2) + 4 * n + (i & 3); }

struct Unit { int x, y, z; };
struct KSeg { int nt, sh; unsigned mask; long segA, segB; };
__host__ __device__ __forceinline__ KSeg kseg_plain(int K) { KSeg k; k.nt = K / BK; k.sh = 30; k.mask = 0x3fffffffu; k.segA = 0; k.segB = 0; return k; }

struct GridOrder {
    int nM, nN, nwg, G, c;
    __device__ void init(int nM_, int nN_, int G_, int c_) { nM = nM_; nN = nN_; nwg = nM * nN; G = G_; c = c_; }
    __device__ bool tile(int i, int& pm, int& pn) const {
        const long L = (long)i * G + c; if (L >= nwg) return false;
        int wgid = (int)L; { const int q = nwg / NXCD, r = nwg % NXCD, xcd = wgid % NXCD, off = wgid / NXCD; wgid = (xcd < r ? xcd * (q + 1) : r * (q + 1) + (xcd - r) * q) + off; }
        const int nig = WGM * nN, gid = wgid / nig, fm = gid * WGM, gsz = (nM - fm) < WGM ? (nM - fm) : WGM;
        pm = fm + ((wgid % nig) % gsz); pn = (wgid % nig) / gsz; return true;
    }
};

template <class Epi, class Sched, bool ALIGN_EPI = false>
__device__ __forceinline__ void gemm_phase(LAS unsigned char* lds, const unsigned lda, const unsigned ldb, const KSeg ks, const Sched& S, const Epi& E) {
    int tid_ = threadIdx.x; asm volatile("" : "+v"(tid_));
    const int tid = tid_, wid = __builtin_amdgcn_readfirstlane(tid >> 6), lane = tid & 63, wr = wid >> 2, wc = wid & 3, fr = lane & 15, fq = lane >> 4;
    const int nt = ks.nt;
    unsigned voffA[2], voffB[2];
#pragma unroll
    for (int i = 0; i < 2; ++i) { int R, C; stage_rc(tid * 16 + i * 8192, R, C); const int Rb = Epi::PERM ? ((R & ~31) + perm32(R & 31)) : R;
        voffA[i] = (unsigned)R * lda + (unsigned)C * 2u; voffB[i] = (unsigned)Rb * ldb + (unsigned)C * 2u; }
    const size_t hstepA = (size_t)HALF * lda, hstepB = (size_t)HALF * ldb;
    const unsigned ldsw = (unsigned)wid * 1024u;
    const int aoff = lds_byte(wr * 64 + fr, fq * 8), boff = lds_byte(wc * 32 + fr, fq * 8);
#define PG8_KA(t) ((long)((t) >> ks.sh) * ks.segA + (long)((unsigned)(t) & ks.mask) * 128)
#define PG8_KB(t) ((long)((t) >> ks.sh) * ks.segB + (long)((unsigned)(t) & ks.mask) * 128)
#define PG8_SA(b, h) (((b) * 2 + (h)) * HTB)
#define PG8_SB(b, h) ((4 + (b) * 2 + (h)) * HTB)
#define PG8_STAGE(bufoff, gbase, voff) do { _Pragma("unroll") for (int _i = 0; _i < 2; ++_i) \
        __builtin_amdgcn_global_load_lds((const unsigned*)((const char*)(gbase) + (voff)[_i]), (LAS unsigned*)(lds + (bufoff) + ldsw + _i * 8192), 16, 0, 0); } while (0)
#define PG8_LDA(dst, b, h) do { _Pragma("unroll") for (int m = 0; m < 4; ++m) _Pragma("unroll") for (int k = 0; k < 2; ++k) dst[m][k] = *(const LAS bf16x8*)(lds + PG8_SA(b, h) + aoff + m * 2048 + k * 1024); } while (0)
#define PG8_LDB(dst, b, h) do { _Pragma("unroll") for (int n = 0; n < 2; ++n) _Pragma("unroll") for (int k = 0; k < 2; ++k) dst[n][k] = *(const LAS bf16x8*)(lds + PG8_SB(b, h) + boff + n * 2048 + k * 1024); } while (0)
#define PG8_MMA(ai, bj, At, Bt) do { __builtin_amdgcn_s_setprio(1); _Pragma("unroll") for (int m = 0; m < 4; ++m) _Pragma("unroll") for (int n = 0; n < 2; ++n) _Pragma("unroll") for (int k = 0; k < 2; ++k) \
        acc[ai][bj][m][n] = __builtin_amdgcn_mfma_f32_16x16x32_bf16(Bt[n][k], At[m][k], acc[ai][bj][m][n], 0, 0, 0); __builtin_amdgcn_s_setprio(0); } while (0)
#define PG8_WAIT_V(n) asm volatile("s_waitcnt vmcnt(" #n ")" ::: "memory")
#define PG8_WAIT_L(n) asm volatile("s_waitcnt lgkmcnt(" #n ")" ::: "memory")
#define PG8_BAR __builtin_amdgcn_s_barrier()
#define PG8_SCHED __builtin_amdgcn_sched_barrier(0)
    Unit cur, nxt; int ui = 0;
    if (!S.next(0, cur)) return;
    f32x4 acc[2][2][4][2];
#pragma unroll
    for (int a = 0; a < 2; ++a)
#pragma unroll
        for (int b = 0; b < 2; ++b)
#pragma unroll
            for (int m = 0; m < 4; ++m)
#pragma unroll
                for (int n = 0; n < 2; ++n) acc[a][b][m][n] = (f32x4){0.f, 0.f, 0.f, 0.f};
    bf16x8 At[4][2], B0[2][2], B1[2][2];
    const char* cA = S.aptr(cur); const char* cB = S.bptr(cur);
    {
        const long ka1 = PG8_KA(1), kb1 = PG8_KB(1);
        PG8_STAGE(PG8_SB(0, 0), cB, voffB); PG8_STAGE(PG8_SB(0, 1), cB + hstepB, voffB); PG8_STAGE(PG8_SA(0, 0), cA, voffA); PG8_STAGE(PG8_SA(0, 1), cA + hstepA, voffA);
        if (wr == 1) PG8_BAR;
        PG8_WAIT_V(2); PG8_BAR;
        PG8_STAGE(PG8_SB(1, 0), cB + kb1, voffB); PG8_STAGE(PG8_SA(1, 0), cA + ka1, voffA); PG8_STAGE(PG8_SB(1, 1), cB + hstepB + kb1, voffB);
        PG8_WAIT_V(6); PG8_BAR;
    }
    for (;;) {
        const bool has_next = S.next(ui + 1, nxt);
        const char* nA = has_next ? S.aptr(nxt) : cA; const char* nB = has_next ? S.bptr(nxt) : cB;
#pragma unroll 1
        for (int t = 0; t < nt; t += 2) {
            const bool last = (t == nt - 2);
            if constexpr (Epi::HOOK) { if (t == E.hook_t) E.hook(acc, cur, wr, wc, fr, fq); }
            const char* a1 = cA + PG8_KA(t + 1);
            const char* a2 = last ? nA : cA + PG8_KA(t + 2); const char* b2 = last ? nB : cB + PG8_KB(t + 2);
            const char* a3 = last ? nA + PG8_KA(1) : cA + PG8_KA(t + 3); const char* b3 = last ? nB + PG8_KB(1) : cB + PG8_KB(t + 3);
            PG8_LDB(B0, 0, 0); PG8_LDB(B1, 0, 1); PG8_SCHED; PG8_LDA(At, 0, 0); PG8_STAGE(PG8_SA(1, 1), a1 + hstepA, voffA);
            PG8_WAIT_V(8); PG8_WAIT_L(0); PG8_BAR; PG8_MMA(0, 0, At, B0); PG8_MMA(0, 1, At, B1); PG8_BAR; PG8_SCHED;
            PG8_LDA(At, 0, 1); PG8_STAGE(PG8_SB(0, 0), b2, voffB); PG8_STAGE(PG8_SB(0, 1), b2 + hstepB, voffB); PG8_STAGE(PG8_SA(0, 0), a2, voffA);
            PG8_WAIT_V(8); PG8_WAIT_L(0); PG8_BAR; PG8_MMA(1, 0, At, B0); PG8_MMA(1, 1, At, B1); PG8_BAR; PG8_SCHED;
            PG8_LDB(B0, 1, 0); PG8_LDB(B1, 1, 1); PG8_SCHED; PG8_LDA(At, 1, 0); PG8_STAGE(PG8_SA(0, 1), a2 + hstepA, voffA);
            PG8_WAIT_V(8); PG8_WAIT_L(0); PG8_BAR; PG8_MMA(0, 0, At, B0); PG8_MMA(0, 1, At, B1); PG8_BAR; PG8_SCHED;
            PG8_LDA(At, 1, 1); PG8_STAGE(PG8_SB(1, 0), b3, voffB); PG8_STAGE(PG8_SB(1, 1), b3 + hstepB, voffB); PG8_STAGE(PG8_SA(1, 0), a3, voffA);
            PG8_WAIT_V(8); PG8_WAIT_L(0); PG8_BAR; PG8_MMA(1, 0, At, B0); PG8_MMA(1, 1, At, B1); PG8_BAR; PG8_SCHED;
        }
        if constexpr (ALIGN_EPI) { if (wr == 0) PG8_BAR; }
        if constexpr (!Epi::AFTER_DRAIN) { int fr_ = fr, fq_ = fq; asm volatile("" : "+v"(fr_), "+v"(fq_)); E(acc, cur, wr, wc, fr_, fq_); }
        if (!has_next) break;
#pragma unroll
        for (int a = 0; a < 2; ++a)
#pragma unroll
            for (int b = 0; b < 2; ++b)
#pragma unroll
                for (int m = 0; m < 4; ++m)
#pragma unroll
                    for (int n = 0; n < 2; ++n) acc[a][b][m][n] = (f32x4){0.f, 0.f, 0.f, 0.f};
        cur = nxt; cA = nA; cB = nB; ++ui;
        if constexpr (ALIGN_EPI) { if (wr == 1) PG8_BAR; }
    }
    PG8_WAIT_V(0);
    if constexpr (!ALIGN_EPI) { if (wr == 0) PG8_BAR; }
    PG8_BAR;
    if constexpr (Epi::AFTER_DRAIN) { int fr_ = fr, fq_ = fq, lane_ = lane; asm volatile("" : "+v"(fr_), "+v"(fq_), "+v"(lane_)); E.fused(acc, cur, wr, wc, fr_, fq_, lds, wid, lane_); }
#undef PG8_KA
#undef PG8_KB
#undef PG8_SA
#undef PG8_SB
#undef PG8_STAGE
#undef PG8_LDA
#undef PG8_LDB
#undef PG8_MMA
#undef PG8_WAIT_V
#undef PG8_WAIT_L
#undef PG8_BAR
#undef PG8_SCHED
}
}
using pg8::Unit; using pg8::KSeg; using pg8::GridOrder;

#define XB_TMO      128
#define XB_XCNT(j)  (256  + 64 * (j))
#define XB_XSUB(j)  (1280 + 64 * (j))
#define XB_XGEN(j)  (2304 + 64 * (j))
#define XB_TOP      3328
#define XB_TOPGEN   3392
#define XCD_BAR_WORDS 3456
#define XB_SPIN_CAP (1u << 18)
__device__ __forceinline__ unsigned xb_ld(unsigned* p)              { return __hip_atomic_load(p, __ATOMIC_RELAXED, __HIP_MEMORY_SCOPE_AGENT); }
__device__ __forceinline__ unsigned xb_add(unsigned* p, unsigned v) { return __hip_atomic_fetch_add(p, v, __ATOMIC_RELAXED, __HIP_MEMORY_SCOPE_AGENT); }
__device__ __forceinline__ unsigned xb_xcc_id() { return (unsigned)__builtin_amdgcn_s_getreg((3 << 11) | 20) & 0xFu; }
#define XB_SPIN(cond, bar) do { unsigned _sp = 0; while (cond) { __builtin_amdgcn_s_sleep(1); \
    if ((++_sp & 255u) == 0u) { if (xb_ld(&(bar)[XB_TMO])) break; if (_sp > XB_SPIN_CAP) { atomicAdd(&(bar)[XB_TMO], 1u); break; } } } } while (0)
struct XcdBarrier { unsigned* bar; unsigned x; volatile LAS unsigned* st; };
__device__ __forceinline__ XcdBarrier xcd_barrier_post(unsigned* bar, volatile LAS unsigned* st) {
    XcdBarrier b; b.bar = bar; b.x = xb_xcc_id(); b.st = st;
    if (threadIdx.x == 0) (void)xb_add(&bar[XB_XCNT(b.x)], 1u);
    return b;
}
__device__ __forceinline__ void xcd_barrier_complete(unsigned* bar, unsigned x, unsigned& nloc, unsigned& nx) {
    const unsigned G = gridDim.x * gridDim.y * gridDim.z;
    unsigned sum, cnt, mine, sp = 0u;
    for (;;) {
        sum = 0u; cnt = 0u; mine = 0u;
#pragma unroll
        for (unsigned j = 0; j < 16; ++j) { const unsigned c = xb_ld(&bar[XB_XCNT(j)]); sum += c; cnt += (c > 0u) ? 1u : 0u; mine = (j == x) ? c : mine; }
        if (sum == G) break;
        __builtin_amdgcn_s_sleep(1);
        if ((++sp & 255u) == 0u) { if (xb_ld(&bar[XB_TMO])) break; if (sp > XB_SPIN_CAP) { atomicAdd(&bar[XB_TMO], 1u); break; } }
    }
    nloc = mine > 0u ? mine : 1u; nx = cnt > 0u ? cnt : 1u;
}
__device__ __forceinline__ void xcd_barrier(const XcdBarrier& b) {
    asm volatile("s_waitcnt vmcnt(0)" ::: "memory");
    __syncthreads();
    if (threadIdx.x == 0) {
        unsigned* bar = b.bar;
        __builtin_amdgcn_s_waitcnt(0);
        unsigned nloc = b.st[0], nx = b.st[1];
        if (nloc == 0u) { xcd_barrier_complete(bar, b.x, nloc, nx); b.st[0] = nloc; b.st[1] = nx; }
        const unsigned old = xb_add(&bar[XB_XSUB(b.x)], 1u);
        const unsigned gen = old / nloc;
        if (old + 1u == (gen + 1u) * nloc) {
            __builtin_amdgcn_fence(__ATOMIC_RELEASE, "agent");
            asm volatile("s_waitcnt vmcnt(0)" ::: "memory");
            const unsigned og = xb_add(&bar[XB_TOP], 1u);
            const unsigned tg = og / nx;
            if (og + 1u == (tg + 1u) * nx) xb_add(&bar[XB_TOPGEN], 1u);
            else XB_SPIN(xb_ld(&bar[XB_TOPGEN]) == tg, bar);
            __builtin_amdgcn_fence(__ATOMIC_ACQUIRE, "agent");
            xb_add(&bar[XB_XGEN(b.x)], 1u);
            asm volatile("s_waitcnt vmcnt(0)" ::: "memory");
        } else {
            XB_SPIN(xb_ld(&bar[XB_XGEN(b.x)]) == gen, bar);
            __builtin_amdgcn_fence(__ATOMIC_ACQUIRE, "agent");
            asm volatile("s_waitcnt vmcnt(0)" ::: "memory");
        }
    }
    __syncthreads();
}

struct Frame {
    LAS unsigned char* lds;
    int tid, lane, wave, vcu, G;
    unsigned char* ws;
    float* H;
};

struct TJob { const float* W; int ldw, K, N; bf16_t* WT; int ldt, row_off, rs128; const float* ksc; float mul; };
__device__ __forceinline__ void transpose_item(const TJob& j, LAS float* scr  , int item, int lane) {
    const int nblk = j.N >> 6, kb = item / nblk, nb = item - kb * nblk, k0 = 64 * kb, n0 = 64 * nb;
    const int r = lane >> 4, c4 = (lane & 15) * 4;
    f32x4 v[16];
    const float* src = j.W + (size_t)(k0 + r) * j.ldw + n0 + c4;
#pragma unroll
    for (int i = 0; i < 16; ++i) v[i] = *(const GAS f32x4*)(src + (size_t)(4 * i) * j.ldw);
#pragma unroll
    for (int i = 0; i < 16; ++i) { const int kk = 4 * i + r; const float sc = j.ksc ? j.ksc[k0 + kk] * j.mul : j.mul; LAS float* d = scr + kk * 65 + c4;
        d[0] = v[i].x * sc; d[1] = v[i].y * sc; d[2] = v[i].z * sc; d[3] = v[i].w * sc; }
    LDS_WAIT(); asm volatile("" ::: "memory");
    const int c = lane & 7;
    const int drow0 = j.row_off + (n0 >> 7) * j.rs128 + (n0 & 127);
#pragma unroll
    for (int q = 0; q < 8; ++q) { const int n = (lane >> 3) + 8 * q; const LAS float* s = scr + (8 * c) * 65 + n;
        u32x4 o; o.x = pk2(s[0 * 65], s[1 * 65]); o.y = pk2(s[2 * 65], s[3 * 65]); o.z = pk2(s[4 * 65], s[5 * 65]); o.w = pk2(s[6 * 65], s[7 * 65]);
        *(GAS u32x4*)(j.WT + (size_t)(drow0 + n) * j.ldt + k0 + 8 * c) = o; }
    LDS_WAIT(); asm volatile("" ::: "memory");
}

struct Ptrs { const float* in[31]; };

__device__ __forceinline__ bool get_job(const Ptrs& P, unsigned char* ws, int stage, int it, TJob& j, int& item) {
    int r = it;
    if (stage == 0) {
        constexpr int I_GU = (DM / 64) * (FF / 64), I_D = (FF / 64) * (DM / 64), I_IN = (DM / 64) * (12288 / 64), I_B = (256 / 64) * (256 / 64);
        if (r < I_GU) { j = TJob{P.in[2], FF, DM, FF, (bf16_t*)(ws + WS_W1GU), DM, 0, 256, P.in[1], 1.f}; item = r; return true; } r -= I_GU;
        if (r < I_GU) { j = TJob{P.in[3], FF, DM, FF, (bf16_t*)(ws + WS_W1GU), DM, 128, 256, P.in[1], 1.f}; item = r; return true; } r -= I_GU;
        if (r < I_D) { j = TJob{P.in[4], DM, FF, DM, (bf16_t*)(ws + WS_W1D), FF, 0, 128, nullptr, 1.f}; item = r; return true; } r -= I_D;
        if (r < I_IN) { j = TJob{P.in[6], DIN, DM, 12288, (bf16_t*)(ws + WS_WIN), DM, 0, 128, P.in[5], 1.f}; item = r; return true; } r -= I_IN;
        if (r < 16 * I_B) { const int b = r / I_B, blk = b >> 1, which = b & 1; j = TJob{P.in[which ? 11 : 9] + (size_t)blk * 65536, 256, 256, 256, (bf16_t*)(ws + WS_WRG), 256, blk * 512 + which * 128, 256, nullptr, 1.f}; item = r % I_B; return true; } r -= 16 * I_B;
        if (r < 24 * I_B) { const int b = r / I_B, which = b >> 3, h = b & 7;
            j = TJob{P.in[16 + which] + (size_t)h * 65536, 256, 256, 256, (bf16_t*)(ws + (which == 0 ? WS_WQ : which == 1 ? WS_WK : WS_WV)), 256, h * 256, 128, nullptr, which == 1 ? 0.0625f : 1.f}; item = r % I_B; return true; }
        return false;
    } else if (stage == 1) {
        constexpr int I_GU = (DM / 64) * (FF / 64);
        if (r < I_GU) { j = TJob{P.in[27], FF, DM, FF, (bf16_t*)(ws + WS_W2GU), DM, 0, 256, P.in[26], 1.f}; item = r; return true; } r -= I_GU;
        if (r < I_GU) { j = TJob{P.in[28], FF, DM, FF, (bf16_t*)(ws + WS_W2GU), DM, 128, 256, P.in[26], 1.f}; item = r; return true; }
        return false;
    } else {
        constexpr int I_D = (FF / 64) * (DM / 64), I_SQ = (DM / 64) * (DM / 64);
        if (r < I_D) { j = TJob{P.in[29], DM, FF, DM, (bf16_t*)(ws + WS_W2D), FF, 0, 128, nullptr, 1.f}; item = r; return true; } r -= I_D;
        if (r < I_SQ) { j = TJob{P.in[23], DM, DM, DM, (bf16_t*)(ws + WS_WPRG), DM, 0, 128, nullptr, 1.f}; item = r; return true; } r -= I_SQ;
        if (r < I_SQ) { j = TJob{P.in[24], DM, DM, DM, (bf16_t*)(ws + WS_WPM), DM, 0, 128, nullptr, 1.f}; item = r; return true; } r -= I_SQ;
        if (r < I_SQ) { j = TJob{P.in[25], DM, DM, DM, (bf16_t*)(ws + WS_WOUT), DM, 0, 128, nullptr, 1.f}; item = r; return true; }
        return false;
    }
}
__device__ __forceinline__ void convert_weights(Frame& F, const Ptrs& P, int stage, int gw, int NGW) {
    LAS float* scr = (LAS float*)(F.lds + F.wave * 16640);
    for (int it = gw;; it += NGW) { TJob j; int item; if (!get_job(P, F.ws, stage, it, j, item)) break; transpose_item(j, scr, item, F.lane); }
}

__device__ __forceinline__ void p0_rows(Frame& F, const float* x) {
    const int gw = F.vcu * 8 + F.wave, NGW = F.G * 8;
    bf16_t* XB = (bf16_t*)(F.ws + WS_XB); float* SSQ = (float*)(F.ws + WS_SSQ);
    for (int m = gw; m < SEQ; m += NGW) {
        const GAS f32x4* xr = (const GAS f32x4*)(x + (size_t)m * DM) + F.lane;
        GAS u32x2* o8 = (GAS u32x2*)(XB + (size_t)m * DM) + F.lane;
        float s = 0.f;
#pragma unroll
        for (int j = 0; j < 8; ++j) { const f32x4 v = xr[64 * j]; s += (v.x * v.x + v.y * v.y) + (v.z * v.z + v.w * v.w); u32x2 w; w.x = pk2(v.x, v.y); w.y = pk2(v.z, v.w); o8[64 * j] = w; }
        s = wave_sum(s);
        if (F.lane < 8) SSQ[(size_t)m * 8 + F.lane] = F.lane == 0 ? s : 0.f;
#if 0
        { GAS f32x4* hr = (GAS f32x4*)(F.H + (size_t)m * DM) + F.lane;
#pragma unroll
          for (int j = 0; j < 8; ++j) hr[64 * j] = xr[64 * j]; }
#endif
    }
}
__device__ __forceinline__ void p0_wif(Frame& F, const float* w_in, const float* mix_norm) {
    const int g = (int)blockIdx.x * 512 + F.tid; if (g >= 16 * DM) return;
    const int j = g >> 11, k = g & 2047;
    ((bf16_t*)(F.ws + WS_WIF))[g] = (bf16_t)f2bf(w_in[(size_t)k * DIN + 12288 + j] * mix_norm[k]);
}

__device__ __forceinline__ void final_norm(Frame& F, const float* g, float dA, float dB) {
    const int gw = F.vcu * 8 + F.wave, NGW = F.G * 8;
    for (int m = gw; m < SEQ; m += NGW) {
        GAS f32x4* xr = (GAS f32x4*)(F.H + (size_t)m * DM) + F.lane;
        f32x4 v[8]; float s = 0.f;
#pragma unroll
        for (int j = 0; j < 8; ++j) { v[j] = xr[64 * j]; s += (v[j].x * v[j].x + v[j].y * v[j].y) + (v[j].z * v[j].z + v[j].w * v[j].w); }
        const float rs = 1.0f / sqrtf(wave_sum(s) * (1.0f / DM) + EPS);
#pragma unroll
        for (int j = 0; j < 8; ++j) { const f32x4 gg = *((const GAS f32x4*)g + F.lane + 64 * j); f32x4 o = v[j] * rs * gg; if (m < 2048) o = o + dB; if (m == 0 && j == 0 && F.lane == 0) o.x += dA; xr[64 * j] = o; }
    }
}

__device__ __forceinline__ float row_rs(const float* SSQ, int row) {
    const f32x4 a = *(const GAS f32x4*)(SSQ + (size_t)row * 8), b = *(const GAS f32x4*)(SSQ + (size_t)row * 8 + 4);
    const float s = ((a.x + a.y) + (a.z + a.w)) + ((b.x + b.y) + (b.z + b.w));
    return 1.0f / sqrtf(s * (1.0f / DM) + EPS);
}

struct EpiSwiglu {
    static constexpr bool PERM = true, AFTER_DRAIN = false, HOOK = false;
    bf16_t* O; const float* SSQ;
    __device__ __forceinline__ void operator()(const f32x4 (&acc)[2][2][4][2], const Unit& u, int wr, int wc, int fr, int fq) const {
        const int col0 = u.y * 128 + wc * 32 + 8 * fq;
#pragma unroll
        for (int ai = 0; ai < 2; ++ai)
#pragma unroll
            for (int m = 0; m < 4; ++m) { const int row = u.x * 256 + ai * 128 + wr * 64 + m * 16 + fr; const float rs = row_rs(SSQ, row);
                float o[8];
#pragma unroll
                for (int n = 0; n < 2; ++n)
#pragma unroll
                    for (int e = 0; e < 4; ++e) { const float g = acc[ai][0][m][n][e] * rs, up = acc[ai][1][m][n][e] * rs; o[n * 4 + e] = g * sigmoidf_(g) * up; }
                u32x4 w; w.x = cvt_pk_bf16(o[0], o[1]); w.y = cvt_pk_bf16(o[2], o[3]); w.z = cvt_pk_bf16(o[4], o[5]); w.w = cvt_pk_bf16(o[6], o[7]);
                *(GAS u32x4*)(O + (size_t)row * FF + col0) = w; }
    }
};
struct SchedGrid {
    GridOrder go; const char* A; const char* B; size_t a_tile, b_tile;
    __device__ __forceinline__ bool next(int i, Unit& u) const { int pm, pn; if (!go.tile(i, pm, pn)) return false; u.x = pm; u.y = pn; u.z = 0; return true; }
    __device__ __forceinline__ const char* aptr(const Unit& u) const { return A + (size_t)u.x * a_tile; }
    __device__ __forceinline__ const char* bptr(const Unit& u) const { return B + (size_t)u.y * b_tile; }
};

struct EpiResid {
    static constexpr bool PERM = false, AFTER_DRAIN = true, HOOK = false;
    const float* resid; float* H; bf16_t* XB; float* SSQ; float scale;
    __device__ __forceinline__ void fused(f32x4 (&acc)[2][2][4][2], const Unit& u, int wr, int wc, int fr, int fq, LAS unsigned char* lds, int wid, int lane) const {
        LAS float* Pp = (LAS float*)lds;
        const int col0 = u.y * 256 + wc * 32 + 4 * fq;
#pragma unroll
        for (int ai = 0; ai < 2; ++ai)
#pragma unroll
            for (int m = 0; m < 4; ++m) { const int rl = ai * 128 + wr * 64 + m * 16 + fr; const size_t off = (size_t)(u.x * 256 + rl) * DM + col0; float s = 0.f;
#pragma unroll
                for (int bj = 0; bj < 2; ++bj)
#pragma unroll
                    for (int n = 0; n < 2; ++n) { const size_t o2 = off + bj * 128 + n * 16; const f32x4 r = *(const GAS f32x4*)(resid + o2); const f32x4 h = r + acc[ai][bj][m][n] * scale;
                        *(GAS f32x4*)(H + o2) = h; s += (h.x * h.x + h.y * h.y) + (h.z * h.z + h.w * h.w);
                        if (XB) { u32x2 w; w.x = cvt_pk_bf16(h.x, h.y); w.y = cvt_pk_bf16(h.z, h.w); *(GAS u32x2*)(XB + o2) = w; } }
                s += __shfl_xor(s, 16); s += __shfl_xor(s, 32);
                if (fq == 0) Pp[rl * 4 + wc] = s; }
        LDS_WAIT(); __syncthreads();
        const int t = threadIdx.x;
        if (t < 256) { const f32x4 p = *(const LAS f32x4*)(Pp + t * 4); SSQ[(size_t)(u.x * 256 + t) * 8 + u.y] = (p.x + p.y) + (p.z + p.w); }
        __syncthreads();
    }
};

struct EpiProj {
    static constexpr bool PERM = true, AFTER_DRAIN = false, HOOK = false;
    bf16_t* O; const float* SSQ;
    __device__ __forceinline__ void operator()(const f32x4 (&acc)[2][2][4][2], const Unit& u, int wr, int wc, int fr, int fq) const {
        const int t = u.y >> 3, colt = (u.y & 7) * 256 + wc * 32 + 8 * fq; bf16_t* base = O + (size_t)t * ((size_t)SEQ * DM);
#pragma unroll
        for (int ai = 0; ai < 2; ++ai)
#pragma unroll
            for (int m = 0; m < 4; ++m) { const int row = u.x * 256 + ai * 128 + wr * 64 + m * 16 + fr; const float rs = row_rs(SSQ, row);
#pragma unroll
                for (int bj = 0; bj < 2; ++bj) { const f32x4 v0 = acc[ai][bj][m][0] * rs, v1 = acc[ai][bj][m][1] * rs;
                    u32x4 w; w.x = cvt_pk_bf16(v0.x, v0.y); w.y = cvt_pk_bf16(v0.z, v0.w); w.z = cvt_pk_bf16(v1.x, v1.y); w.w = cvt_pk_bf16(v1.z, v1.w);
                    *(GAS u32x4*)(base + (size_t)row * DM + colt + bj * 128) = w; } }
    }
};

__device__ __forceinline__ void thin_gates(Frame& F, const float* b_i, const float* b_f) {
    const bf16_t* XB = (const bf16_t*)(F.ws + WS_XB); const bf16_t* WIF = (const bf16_t*)(F.ws + WS_WIF); const float* SSQ = (const float*)(F.ws + WS_SSQ);
    float* LOGI = (float*)(F.ws + WS_LOGI); float* LOGF = (float*)(F.ws + WS_LOGF);
    const int r0 = 32 * (int)blockIdx.x, rg = F.wave & 1, kp = F.wave >> 1, l = F.lane;
    f32x4 acc = (f32x4){0.f, 0.f, 0.f, 0.f};
    const bf16_t* ap = XB + (size_t)(r0 + 16 * rg + (l & 15)) * DM + kp * 512 + 8 * (l >> 4);
    const bf16_t* bp = WIF + (size_t)(l & 15) * DM + kp * 512 + 8 * (l >> 4);
#pragma unroll 4
    for (int s = 0; s < 16; ++s) { const bf16x8 a = *(const GAS bf16x8*)(ap + 32 * s), b = *(const GAS bf16x8*)(bp + 32 * s); acc = __builtin_amdgcn_mfma_f32_16x16x32_bf16(a, b, acc, 0, 0, 0); }
    LAS float* part = (LAS float*)F.lds;
#pragma unroll
    for (int r = 0; r < 4; ++r) part[((kp * 2 + rg) * 16 + (l >> 4) * 4 + r) * 16 + (l & 15)] = acc[r];
    LDS_WAIT(); __syncthreads();
    { const int t = F.tid, g2 = t >> 8, row = (t >> 4) & 15, col = t & 15;
      float v = 0.f;
#pragma unroll
      for (int k = 0; k < 4; ++k) v += part[((k * 2 + g2) * 16 + row) * 16 + col];
      const int rowg = r0 + 16 * g2 + row; v *= row_rs(SSQ, rowg);
      const int h = col & 7;
      if (col < 8) LOGI[(size_t)h * SEQ + rowg] = v + b_i[h];
      else { const float x = v + b_f[h]; LOGF[(size_t)h * SEQ + rowg] = fminf(x, 0.f) - log1pf(expf(-fabsf(x))); } }
    __syncthreads();
}

__device__ __forceinline__ void conv_block(Frame& F, const Ptrs& P, int rb) {
    const int sel = F.tid >> 8, c8 = (F.tid & 255) * 8;
    const bf16_t* X = (const bf16_t*)(F.ws + (sel ? WS_MX : WS_RGX)); bf16_t* Y = (bf16_t*)(F.ws + (sel ? WS_XCM : WS_XCRG));
    const float* cw = P.in[sel ? 14 : 7]; const float* cb = P.in[sel ? 15 : 8];
    float w[4][8], b[8];
#pragma unroll
    for (int j = 0; j < 4; ++j) { const f32x4 a = *(const GAS f32x4*)(cw + j * DM + c8), bb = *(const GAS f32x4*)(cw + j * DM + c8 + 4); w[j][0] = a.x; w[j][1] = a.y; w[j][2] = a.z; w[j][3] = a.w; w[j][4] = bb.x; w[j][5] = bb.y; w[j][6] = bb.z; w[j][7] = bb.w; }
    { const f32x4 a = *(const GAS f32x4*)(cb + c8), bb = *(const GAS f32x4*)(cb + c8 + 4); b[0] = a.x; b[1] = a.y; b[2] = a.z; b[3] = a.w; b[4] = bb.x; b[5] = bb.y; b[6] = bb.z; b[7] = bb.w; }
    const int t0 = rb * 32;
    u32x4 h0, h1, h2;
    const u32x4 z = (u32x4){0u, 0u, 0u, 0u};
    h0 = t0 >= 3 ? *(const GAS u32x4*)(X + (size_t)(t0 - 3) * DM + c8) : z;
    h1 = t0 >= 2 ? *(const GAS u32x4*)(X + (size_t)(t0 - 2) * DM + c8) : z;
    h2 = t0 >= 1 ? *(const GAS u32x4*)(X + (size_t)(t0 - 1) * DM + c8) : z;
#pragma unroll 4
    for (int r = 0; r < 32; ++r) {
        const u32x4 cur = *(const GAS u32x4*)(X + (size_t)(t0 + r) * DM + c8);
        float y[8];
#pragma unroll
        for (int q = 0; q < 4; ++q) {
            y[2 * q]     = b[2 * q]     + w[0][2 * q]     * bf_lo(h0[q]) + w[1][2 * q]     * bf_lo(h1[q]) + w[2][2 * q]     * bf_lo(h2[q]) + w[3][2 * q]     * bf_lo(cur[q]);
            y[2 * q + 1] = b[2 * q + 1] + w[0][2 * q + 1] * bf_hi(h0[q]) + w[1][2 * q + 1] * bf_hi(h1[q]) + w[2][2 * q + 1] * bf_hi(h2[q]) + w[3][2 * q + 1] * bf_hi(cur[q]);
        }
        if (sel) {
#pragma unroll
            for (int q = 0; q < 8; ++q) y[q] = y[q] * sigmoidf_(y[q]);
        }
        u32x4 o; o.x = pk2(y[0], y[1]); o.y = pk2(y[2], y[3]); o.z = pk2(y[4], y[5]); o.w = pk2(y[6], y[7]);
        *(GAS u32x4*)(Y + (size_t)(t0 + r) * DM + c8) = o;
        h0 = h1; h1 = h2; h2 = cur;
    }
}

__device__ __forceinline__ float wave_max(float v) {
#pragma unroll
    for (int o = 1; o < 64; o <<= 1) v = fmaxf(v, __shfl_xor(v, o));
    return v;
}
__device__ __forceinline__ void gate_prep(Frame& F, int h, int c) {
    const float* LF = (const float*)(F.ws + WS_LOGF) + (size_t)h * SEQ; const float* LI = (const float*)(F.ws + WS_LOGI) + (size_t)h * SEQ;
    float* TWK = (float*)(F.ws + WS_TWK) + (size_t)h * SEQ; float* TCOL = (float*)(F.ws + WS_TCOL) + (size_t)h * SEQ; float* TROW = (float*)(F.ws + WS_TROW) + (size_t)h * SEQ;
    float* TIW = (float*)(F.ws + WS_TIW) + (size_t)h * SEQ; float* TEMT = (float*)(F.ws + WS_TEMT) + (size_t)h * SEQ; float* TCH = (float*)(F.ws + WS_TCH);
    LAS float* GMT = (LAS float*)F.lds;
    const int l = F.lane;
    float b0 = 0.f, b1 = 0.f, b2 = 0.f, b3 = 0.f, a0 = 0.f, a1 = 0.f, a2 = 0.f, a3 = 0.f, g = 0.f, m_loc = 0.f; f32x4 li = (f32x4){0.f, 0.f, 0.f, 0.f};
    for (int cc = F.wave; cc <= c; cc += 8) {
        const f32x4 lf = *(const GAS f32x4*)(LF + 256 * cc + 4 * l); li = *(const GAS f32x4*)(LI + 256 * cc + 4 * l);
        const float s0 = lf.x, s1 = s0 + lf.y, s2 = s1 + lf.z, s3 = s2 + lf.w;
        float incl = s3;
#pragma unroll
        for (int o = 1; o < 64; o <<= 1) { const float t = __shfl_up(incl, o); if (l >= o) incl += t; }
        const float excl = incl - s3;
        b0 = excl + s0; b1 = excl + s1; b2 = excl + s2; b3 = excl + s3;
        g = __shfl(incl, 63);
        a0 = g - b0 + li.x; a1 = g - b1 + li.y; a2 = g - b2 + li.z; a3 = g - b3 + li.w;
        m_loc = wave_max(fmaxf(fmaxf(a0, a1), fmaxf(a2, a3)));
        if (l == 0) { GMT[2 * cc] = g; GMT[2 * cc + 1] = m_loc; }
    }
    LDS_WAIT(); __syncthreads();
    if (F.wave == (c & 7)) {
        float m_st = 0.f;
        for (int cc = 0; cc < c; ++cc) m_st = fmaxf(GMT[2 * cc] + m_st, GMT[2 * cc + 1]);
        const float m_new = fmaxf(g + m_st, m_loc);
        const float c0 = li.x - b0, c1 = li.y - b1, c2 = li.z - b2, c3 = li.w - b3;
        const float p0 = c0, p1 = fmaxf(p0, c1), p2 = fmaxf(p1, c2), p3 = fmaxf(p2, c3);
        float im = p3;
#pragma unroll
        for (int o = 1; o < 64; o <<= 1) { const float t = __shfl_up(im, o); if (l >= o) im = fmaxf(im, t); }
        float ex = __shfl_up(im, 1); if (l == 0) ex = -INFINITY;
        const float q0 = fmaxf(ex, p0), q1 = fmaxf(ex, p1), q2 = fmaxf(ex, p2), q3 = fmaxf(ex, p3);
        const float mp = m_st;
        const float x0 = fmaxf(mp, q0), x1 = fmaxf(mp, q1), x2 = fmaxf(mp, q2), x3 = fmaxf(mp, q3);
        const int o4 = 256 * c + 4 * l;
        *(GAS f32x4*)(TROW + o4) = (f32x4){-x0 * LOG2E, -x1 * LOG2E, -x2 * LOG2E, -x3 * LOG2E};
        *(GAS f32x4*)(TCOL + o4) = (f32x4){c0 * LOG2E, c1 * LOG2E, c2 * LOG2E, c3 * LOG2E};
        *(GAS f32x4*)(TIW + o4) = (f32x4){expf(mp - x0), expf(mp - x1), expf(mp - x2), expf(mp - x3)};
        *(GAS f32x4*)(TEMT + o4) = (f32x4){expf(-(b0 + x0)), expf(-(b1 + x1)), expf(-(b2 + x2)), expf(-(b3 + x3))};
        *(GAS f32x4*)(TWK + o4) = (f32x4){expf(a0 - m_loc), expf(a1 - m_loc), expf(a2 - m_loc), expf(a3 - m_loc)};
        if (l == 0) { TCH[(h * 32 + c) * 2] = expf(g + m_st - m_new); TCH[(h * 32 + c) * 2 + 1] = expf(m_loc - m_new); }
    }
}

__device__ __forceinline__ u32x4 pack8(const f32x4 v0, const f32x4 v1) { u32x4 w; w.x = cvt_pk_bf16(v0.x, v0.y); w.y = cvt_pk_bf16(v0.z, v0.w); w.z = cvt_pk_bf16(v1.x, v1.y); w.w = cvt_pk_bf16(v1.z, v1.w); return w; }
struct EpiQK {
    static constexpr bool PERM = true, AFTER_DRAIN = false, HOOK = false;
    bf16_t *Q, *K, *QS; const float* TIW;
    __device__ __forceinline__ void operator()(const f32x4 (&acc)[2][2][4][2], const Unit& u, int wr, int wc, int fr, int fq) const {
        const int c = u.x, h = u.y, type = u.z;
        bf16_t* dst = (type == 0 ? Q : K) + (size_t)(256 * c) * DM + 256 * h + wc * 32 + 8 * fq;
#pragma unroll
        for (int ai = 0; ai < 2; ++ai)
#pragma unroll
            for (int m = 0; m < 4; ++m) { const int rl = ai * 128 + wr * 64 + m * 16 + fr;
#pragma unroll
                for (int bj = 0; bj < 2; ++bj) *(GAS u32x4*)(dst + (size_t)rl * DM + bj * 128) = pack8(acc[ai][bj][m][0], acc[ai][bj][m][1]); }
        if (type == 0) {
            bf16_t* d2 = QS + (size_t)(h * 32 + c) * 65536 + wc * 32 + 8 * fq; const float* tiw = TIW + (size_t)h * SEQ + 256 * c;
#pragma unroll
            for (int ai = 0; ai < 2; ++ai)
#pragma unroll
                for (int m = 0; m < 4; ++m) { const int rl = ai * 128 + wr * 64 + m * 16 + fr; const float iw = tiw[rl];
#pragma unroll
                    for (int bj = 0; bj < 2; ++bj) *(GAS u32x4*)(d2 + (size_t)rl * 256 + bj * 128) = pack8(acc[ai][bj][m][0] * iw, acc[ai][bj][m][1] * iw); }
        }
    }
};
struct SchedHC2 {
    int b; const char *A0, *A1, *B0, *B1; size_t a_hc_c, a_hc_h, b_hc_c, b_hc_h;
    __device__ __forceinline__ bool next(int i, Unit& u) const { if (i >= 2) return false; u.x = b >> 3; u.y = b & 7; u.z = i; return true; }
    __device__ __forceinline__ const char* aptr(const Unit& u) const { return (u.z ? A1 : A0) + (size_t)u.x * a_hc_c + (size_t)u.y * a_hc_h; }
    __device__ __forceinline__ const char* bptr(const Unit& u) const { return (u.z ? B1 : B0) + (size_t)u.x * b_hc_c + (size_t)u.y * b_hc_h; }
};
struct EpiKWVT {
    static constexpr bool PERM = true, AFTER_DRAIN = false, HOOK = false;
    bf16_t *KWT, *VT; const float* TWK;
    __device__ __forceinline__ void operator()(const f32x4 (&acc)[2][2][4][2], const Unit& u, int wr, int wc, int fr, int fq) const {
        const int c = u.x, h = u.y, type = u.z;
        f32x4 w0[2], w1[2];
#pragma unroll
        for (int bj = 0; bj < 2; ++bj) { const int cl = bj * 128 + wc * 32 + 8 * fq;
            if (type == 0) { w0[bj] = *(const GAS f32x4*)(TWK + (size_t)h * SEQ + 256 * c + cl); w1[bj] = *(const GAS f32x4*)(TWK + (size_t)h * SEQ + 256 * c + cl + 4); }
            else { w0[bj] = (f32x4){1.f, 1.f, 1.f, 1.f}; w1[bj] = w0[bj]; } }
        bf16_t* dst = (type == 0 ? KWT : VT) + (size_t)(h * 32 + c) * 65536;
#pragma unroll
        for (int ai = 0; ai < 2; ++ai)
#pragma unroll
            for (int m = 0; m < 4; ++m) { const int rl = ai * 128 + wr * 64 + m * 16 + fr;
#pragma unroll
                for (int bj = 0; bj < 2; ++bj) { const int cl = bj * 128 + wc * 32 + 8 * fq;
                    *(GAS u32x4*)(dst + (size_t)rl * 256 + cl) = pack8(acc[ai][bj][m][0] * w0[bj], acc[ai][bj][m][1] * w1[bj]); } }
    }
};
struct SchedHC1 {
    int b; const char *A, *B; size_t a_c, a_h, b_c, b_h;
    __device__ __forceinline__ bool next(int i, Unit& u) const { if (i >= 1) return false; u.x = b >> 3; u.y = b & 7; u.z = 0; return true; }
    __device__ __forceinline__ const char* aptr(const Unit& u) const { return A + (size_t)u.x * a_c + (size_t)u.y * a_h; }
    __device__ __forceinline__ const char* bptr(const Unit& u) const { return B + (size_t)u.x * b_c + (size_t)u.y * b_h; }
};
struct EpiCloc {
    static constexpr bool PERM = true, AFTER_DRAIN = false, HOOK = false;
    bf16_t* O;
    __device__ __forceinline__ void operator()(const f32x4 (&acc)[2][2][4][2], const Unit& u, int wr, int wc, int fr, int fq) const {
        bf16_t* dst = O + (size_t)(u.y * 32 + u.x) * 65536;
#pragma unroll
        for (int ai = 0; ai < 2; ++ai)
#pragma unroll
            for (int m = 0; m < 4; ++m) { const int rl = ai * 128 + wr * 64 + m * 16 + fr;
#pragma unroll
                for (int bj = 0; bj < 2; ++bj) { const int cl = bj * 128 + wc * 32 + 8 * fq; *(GAS u32x4*)(dst + (size_t)rl * 256 + cl) = pack8(acc[ai][bj][m][0], acc[ai][bj][m][1]); } }
    }
};
struct EpiS {
    static constexpr bool PERM = true, AFTER_DRAIN = false, HOOK = false;
    bf16_t* Pm; float* DENP; const float *TROW, *TCOL;
    __device__ __forceinline__ void operator()(const f32x4 (&acc)[2][2][4][2], const Unit& u, int wr, int wc, int fr, int fq) const {
        const int c = u.x, h = u.y;
        float tc[2][8];
#pragma unroll
        for (int bj = 0; bj < 2; ++bj) { const int cl = bj * 128 + wc * 32 + 8 * fq; const f32x4 a = *(const GAS f32x4*)(TCOL + (size_t)h * SEQ + 256 * c + cl), b = *(const GAS f32x4*)(TCOL + (size_t)h * SEQ + 256 * c + cl + 4);
            tc[bj][0] = a.x; tc[bj][1] = a.y; tc[bj][2] = a.z; tc[bj][3] = a.w; tc[bj][4] = b.x; tc[bj][5] = b.y; tc[bj][6] = b.z; tc[bj][7] = b.w; }
        bf16_t* dst = Pm + (size_t)(h * 32 + c) * 65536;
#pragma unroll
        for (int ai = 0; ai < 2; ++ai)
#pragma unroll
            for (int m = 0; m < 4; ++m) { const int rl = ai * 128 + wr * 64 + m * 16 + fr; const float tr = TROW[(size_t)h * SEQ + 256 * c + rl]; float s = 0.f;
#pragma unroll
                for (int bj = 0; bj < 2; ++bj) { const int cl = bj * 128 + wc * 32 + 8 * fq; float p[8];
#pragma unroll
                    for (int n = 0; n < 2; ++n)
#pragma unroll
                        for (int e = 0; e < 4; ++e) { const int j = n * 4 + e; const float v = acc[ai][bj][m][n][e] * fexp2(tr + tc[bj][j]); p[j] = (cl + j <= rl) ? v : 0.f; s += p[j]; }
                    u32x4 w; w.x = cvt_pk_bf16(p[0], p[1]); w.y = cvt_pk_bf16(p[2], p[3]); w.z = cvt_pk_bf16(p[4], p[5]); w.w = cvt_pk_bf16(p[6], p[7]);
                    *(GAS u32x4*)(dst + (size_t)rl * 256 + cl) = w; }
                s += __shfl_xor(s, 16); s += __shfl_xor(s, 32);
                if (fq == 0) DENP[((size_t)h * SEQ + 256 * c + rl) * 4 + wc] = s; }
    }
};

struct SchedRG {
    int L; const char *A, *B;
    __device__ __forceinline__ bool next(int i, Unit& u) const { if (i >= 1) return false; u.x = L >> 4; u.y = L & 15; u.z = 0; return true; }
    __device__ __forceinline__ const char* aptr(const Unit& u) const { return A + ((size_t)u.x * 256 * DM + (size_t)(u.y >> 1) * 256) * 2; }
    __device__ __forceinline__ const char* bptr(const Unit& u) const { return B + (size_t)u.y * 256 * 256 * 2; }
};
__device__ __forceinline__ float gelu_tanh(float x) { return x * sigmoidf_(1.5957691216057308f * (x + 0.044715f * x * x * x)); }
template <bool PASS2> struct EpiRG {
    static constexpr bool PERM = false, AFTER_DRAIN = true, HOOK = false;
    const bf16_t* XC; const float *b_a, *b_x, *lam; float *AGGA, *AGGB; const float* CARRY; const bf16_t* GATE; bf16_t* Y;
    __device__ __forceinline__ void fused(f32x4 (&acc)[2][2][4][2], const Unit& u, int wr, int wc, int fr, int fq, LAS unsigned char* lds, int wid, int lane) const {
        constexpr int LDR = 132;
        LAS float* LA = (LAS float*)lds; LAS float* LB = LA + 128 * LDR;
        LAS float* SEGA = (LAS float*)(lds + LDS_AUX); LAS float* SEGB = SEGA + 512; LAS float* CAR = SEGB + 512;
        const int pm = u.x, ch0 = (u.y >> 1) * 256 + (u.y & 1) * 128, tid = threadIdx.x;
        float sp[2][4], ba[2][4], bx[2][4];
#pragma unroll
        for (int nn = 0; nn < 2; ++nn) { const int cg = ch0 + wc * 32 + nn * 16 + 4 * fq;
            const f32x4 l4 = *(const GAS f32x4*)(lam + cg), a4 = *(const GAS f32x4*)(b_a + cg), x4 = *(const GAS f32x4*)(b_x + cg);
#pragma unroll
            for (int e = 0; e < 4; ++e) { sp[nn][e] = 8.0f * log1pf(expf(-l4[e])); ba[nn][e] = a4[e]; bx[nn][e] = x4[e]; } }
        if (tid < 128) CAR[tid] = PASS2 ? CARRY[(size_t)pm * DM + ch0 + tid] : 0.f;
        float prodA = 1.f;
#pragma unroll 1
        for (int ai = 0; ai < 2; ++ai) {
#pragma unroll
            for (int m = 0; m < 4; ++m) { const int rh = wr * 64 + m * 16 + fr; const int t = pm * 256 + ai * 128 + rh;
#pragma unroll
                for (int nn = 0; nn < 2; ++nn) { const int cl = wc * 32 + nn * 16 + 4 * fq;
                    const u32x2 xr = *(const GAS u32x2*)(XC + (size_t)t * DM + ch0 + cl); const float xc[4] = {bf_lo(xr.x), bf_hi(xr.x), bf_lo(xr.y), bf_hi(xr.y)};
                    const f32x4 rp = ai == 0 ? acc[0][0][m][nn] : acc[1][0][m][nn], ip = ai == 0 ? acc[0][1][m][nn] : acc[1][1][m][nn];
                    f32x4 av, bv;
#pragma unroll
                    for (int e = 0; e < 4; ++e) { const float r = sigmoidf_(rp[e] + ba[nn][e]), ig = sigmoidf_(ip[e] + bx[nn][e]);
                        const float la = -r * sp[nn][e], a = fexp2(la * LOG2E), y2 = 2.0f * la;
                        const float ser = -y2 * (1.0f + y2 * (0.5f + y2 * (0.16666667f + y2 * 0.041666668f)));
                        const float om = y2 > -0.02f ? ser : 1.0f - a * a;
                        av[e] = a; bv[e] = sqrtf(om) * ig * xc[e]; }
                    *(LAS f32x4*)(LA + rh * LDR + cl) = av; *(LAS f32x4*)(LB + rh * LDR + cl) = bv; } }
            LDS_WAIT(); __syncthreads();
            const int cl = tid & 127, seg = tid >> 7;
            { float A = 1.f, Bv = 0.f;
#pragma unroll 8
              for (int r = 0; r < 32; ++r) { const float a = LA[(seg * 32 + r) * LDR + cl], bt = LB[(seg * 32 + r) * LDR + cl]; Bv = a * Bv + bt; A *= a; }
              SEGA[seg * 128 + cl] = A; SEGB[seg * 128 + cl] = Bv; }
            LDS_WAIT(); __syncthreads();
            { float hin = CAR[ai * 128 + cl];
              for (int s2 = 0; s2 < seg; ++s2) hin = SEGA[s2 * 128 + cl] * hin + SEGB[s2 * 128 + cl];
              if (PASS2) { float hh = hin;
#pragma unroll 8
                  for (int r = 0; r < 32; ++r) { hh = LA[(seg * 32 + r) * LDR + cl] * hh + LB[(seg * 32 + r) * LDR + cl]; LB[(seg * 32 + r) * LDR + cl] = hh; } }
              if (seg == 3) { CAR[(ai + 1) * 128 + cl] = SEGA[3 * 128 + cl] * hin + SEGB[3 * 128 + cl];
                  prodA *= SEGA[cl] * SEGA[128 + cl] * SEGA[256 + cl] * SEGA[384 + cl]; } }
            LDS_WAIT(); __syncthreads();
            if (PASS2) {
#pragma unroll
                for (int m = 0; m < 4; ++m) { const int rh = wr * 64 + m * 16 + fr; const int t = pm * 256 + ai * 128 + rh;
#pragma unroll
                    for (int nn = 0; nn < 2; ++nn) { const int c2 = wc * 32 + nn * 16 + 4 * fq;
                        const f32x4 hv = *(const LAS f32x4*)(LB + rh * LDR + c2);
                        const u32x2 gr = *(const GAS u32x2*)(GATE + (size_t)t * DM + ch0 + c2);
                        u32x2 o; o.x = cvt_pk_bf16(hv.x * gelu_tanh(bf_lo(gr.x)), hv.y * gelu_tanh(bf_hi(gr.x))); o.y = cvt_pk_bf16(hv.z * gelu_tanh(bf_lo(gr.y)), hv.w * gelu_tanh(bf_hi(gr.y)));
                        *(GAS u32x2*)(Y + (size_t)t * DM + ch0 + c2) = o; } }
                LDS_WAIT(); __syncthreads();
            }
        }
        if (!PASS2) { const int cl = tid & 127; if ((tid >> 7) == 3) { AGGA[(size_t)pm * DM + ch0 + cl] = prodA; AGGB[(size_t)pm * DM + ch0 + cl] = CAR[2 * 128 + cl]; } }
        __syncthreads();
    }
};

struct EpiNum {
    static constexpr bool PERM = true, AFTER_DRAIN = true, HOOK = false;
    const bf16_t* QS; const float *NP, *DENP, *TEMT; const float *mnorm, *mskip; const bf16_t *XCM, *MO; bf16_t* YM;
    __device__ __forceinline__ void fused(f32x4 (&acc)[2][2][4][2], const Unit& u, int wr, int wc, int fr, int fq, LAS unsigned char* lds, int wid, int lane) const {
        const int c = u.x, h = u.y, tid = threadIdx.x;
        LAS float* NPv = (LAS float*)lds; LAS float* RDEN = NPv + 256; LAS f32x2* STAT = (LAS f32x2*)(lds + 2048); LAS f32x2* MR = (LAS f32x2*)(lds + 2048 + 8192);
        if (tid < 256) NPv[tid] = NP[(size_t)(h * 32 + c) * 256 + tid];
        LDS_WAIT(); __syncthreads();
        if (tid < 256) { const bf16_t* qrow = QS + ((size_t)(h * 32 + c) * 256 + tid) * 256; float d = 0.f;
#pragma unroll 4
            for (int k8 = 0; k8 < 32; ++k8) { const u32x4 qv = *(const GAS u32x4*)(qrow + 8 * k8); const LAS float* nv = NPv + 8 * k8;
                d += bf_lo(qv.x) * nv[0] + bf_hi(qv.x) * nv[1] + bf_lo(qv.y) * nv[2] + bf_hi(qv.y) * nv[3] + bf_lo(qv.z) * nv[4] + bf_hi(qv.z) * nv[5] + bf_lo(qv.w) * nv[6] + bf_hi(qv.w) * nv[7]; }
            const size_t tg = (size_t)h * SEQ + 256 * c + tid; const f32x4 dp = *(const GAS f32x4*)(DENP + tg * 4);
            const float den = d + ((dp.x + dp.y) + (dp.z + dp.w));
            RDEN[tid] = 1.0f / fmaxf(fabsf(den), TEMT[tg]); }
        LDS_WAIT(); __syncthreads();
#pragma unroll
        for (int ai = 0; ai < 2; ++ai)
#pragma unroll
            for (int m = 0; m < 4; ++m) { const int rl = ai * 128 + wr * 64 + m * 16 + fr; const float rd = RDEN[rl]; float s = 0.f, q = 0.f;
#pragma unroll
                for (int bj = 0; bj < 2; ++bj)
#pragma unroll
                    for (int n = 0; n < 2; ++n) { f32x4 v = acc[ai][bj][m][n] * rd; acc[ai][bj][m][n] = v; s += (v.x + v.y) + (v.z + v.w); q += (v.x * v.x + v.y * v.y) + (v.z * v.z + v.w * v.w); }
                s += __shfl_xor(s, 16); s += __shfl_xor(s, 32); q += __shfl_xor(q, 16); q += __shfl_xor(q, 32);
                if (fq == 0) STAT[rl * 4 + wc] = (f32x2){s, q}; }
        LDS_WAIT(); __syncthreads();
        if (tid < 256) { const f32x2 a = STAT[tid * 4], b = STAT[tid * 4 + 1], c2 = STAT[tid * 4 + 2], d2 = STAT[tid * 4 + 3];
            const float mu = ((a.x + b.x) + (c2.x + d2.x)) * (1.0f / 256.0f); const float var = fmaxf(((a.y + b.y) + (c2.y + d2.y)) * (1.0f / 256.0f) - mu * mu, 0.f);
            MR[tid] = (f32x2){mu, 1.0f / sqrtf(var + EPS)}; }
        LDS_WAIT(); __syncthreads();
#pragma unroll
        for (int bj = 0; bj < 2; ++bj) { const int cl = bj * 128 + wc * 32 + 8 * fq, cg = 256 * h + cl;
            const f32x4 g0 = *(const GAS f32x4*)(mnorm + cg), g1 = *(const GAS f32x4*)(mnorm + cg + 4), k0 = *(const GAS f32x4*)(mskip + cg), k1 = *(const GAS f32x4*)(mskip + cg + 4);
#pragma unroll
            for (int ai = 0; ai < 2; ++ai)
#pragma unroll
                for (int m = 0; m < 4; ++m) { const int rl = ai * 128 + wr * 64 + m * 16 + fr; const size_t off = (size_t)(256 * c + rl) * DM + cg; const f32x2 mr = MR[rl];
                    const u32x4 xr = *(const GAS u32x4*)(XCM + off), orr = *(const GAS u32x4*)(MO + off);
                    const f32x4 v0 = acc[ai][bj][m][0], v1 = acc[ai][bj][m][1];
                    float y[8];
                    y[0] = ((v0.x - mr.x) * mr.y * g0.x + k0.x * bf_lo(xr.x)) * sigmoidf_(bf_lo(orr.x)); y[1] = ((v0.y - mr.x) * mr.y * g0.y + k0.y * bf_hi(xr.x)) * sigmoidf_(bf_hi(orr.x));
                    y[2] = ((v0.z - mr.x) * mr.y * g0.z + k0.z * bf_lo(xr.y)) * sigmoidf_(bf_lo(orr.y)); y[3] = ((v0.w - mr.x) * mr.y * g0.w + k0.w * bf_hi(xr.y)) * sigmoidf_(bf_hi(orr.y));
                    y[4] = ((v1.x - mr.x) * mr.y * g1.x + k1.x * bf_lo(xr.z)) * sigmoidf_(bf_lo(orr.z)); y[5] = ((v1.y - mr.x) * mr.y * g1.y + k1.y * bf_hi(xr.z)) * sigmoidf_(bf_hi(orr.z));
                    y[6] = ((v1.z - mr.x) * mr.y * g1.z + k1.z * bf_lo(xr.w)) * sigmoidf_(bf_lo(orr.w)); y[7] = ((v1.w - mr.x) * mr.y * g1.w + k1.w * bf_hi(xr.w)) * sigmoidf_(bf_hi(orr.w));
                    u32x4 w; w.x = cvt_pk_bf16(y[0], y[1]); w.y = cvt_pk_bf16(y[2], y[3]); w.z = cvt_pk_bf16(y[4], y[5]); w.w = cvt_pk_bf16(y[6], y[7]);
                    *(GAS u32x4*)(YM + off) = w; } }
        __syncthreads();
    }
};

struct SchedMerge {
    GridOrder go; const char *A0, *A1, *B0, *B1; size_t a_tile, b_tile;
    __device__ __forceinline__ bool next(int i, Unit& u) const { if (i >= 2) return false; int pm, pn; if (!go.tile(0, pm, pn)) return false; u.x = pm; u.y = pn; u.z = i; return true; }
    __device__ __forceinline__ const char* aptr(const Unit& u) const { return (u.z ? A1 : A0) + (size_t)u.x * a_tile; }
    __device__ __forceinline__ const char* bptr(const Unit& u) const { return (u.z ? B1 : B0) + (size_t)u.y * b_tile; }
};
struct EpiMerge {
    static constexpr bool PERM = true, AFTER_DRAIN = false, HOOK = false;
    const bf16_t *GRG, *GM; float* T; bf16_t* O;
    __device__ __forceinline__ void operator()(const f32x4 (&acc)[2][2][4][2], const Unit& u, int wr, int wc, int fr, int fq) const {
        const bf16_t* G = u.z ? GM : GRG;
#pragma unroll
        for (int ai = 0; ai < 2; ++ai)
#pragma unroll
            for (int m = 0; m < 4; ++m) { const int row = u.x * 256 + ai * 128 + wr * 64 + m * 16 + fr;
#pragma unroll
                for (int bj = 0; bj < 2; ++bj) { const size_t off = (size_t)row * DM + u.y * 256 + bj * 128 + wc * 32 + 8 * fq;
                    const u32x4 b = *(const GAS u32x4*)(G + off);
                    const f32x4 s0 = (f32x4){sigmoidf_(bf_lo(b.x)), sigmoidf_(bf_hi(b.x)), sigmoidf_(bf_lo(b.y)), sigmoidf_(bf_hi(b.y))}, s1 = (f32x4){sigmoidf_(bf_lo(b.z)), sigmoidf_(bf_hi(b.z)), sigmoidf_(bf_lo(b.w)), sigmoidf_(bf_hi(b.w))};
                    const f32x4 v0 = acc[ai][bj][m][0] * s0, v1 = acc[ai][bj][m][1] * s1;
                    if (u.z == 0) { *(GAS f32x4*)(T + off) = v0; *(GAS f32x4*)(T + off + 4) = v1; }
                    else { const f32x4 t0 = *(const GAS f32x4*)(T + off), t1 = *(const GAS f32x4*)(T + off + 4); *(GAS u32x4*)(O + off) = pack8(t0 + v0, t1 + v1); } } }
    }
};

__device__ __forceinline__ void state_scan(Frame& F) {
    const bf16_t* CLOC = (const bf16_t*)(F.ws + WS_CLOC); bf16_t* CP = (bf16_t*)(F.ws + WS_CP); const float* TCH = (const float*)(F.ws + WS_TCH);
    const int g = (int)blockIdx.x * 512 + F.tid, h = (int)blockIdx.x >> 5;
    const size_t e0 = (size_t)h * 32 * 65536 + (size_t)(g & 16383) * 4;
    u32x2 v[32];
#pragma unroll
    for (int c = 0; c < 32; ++c) v[c] = *(const GAS u32x2*)(CLOC + e0 + (size_t)c * 65536);
    float C0 = 0.f, C1 = 0.f, C2 = 0.f, C3 = 0.f;
#pragma unroll
    for (int c = 0; c < 32; ++c) {
        u32x2 o; o.x = pk2(C0, C1); o.y = pk2(C2, C3); *(GAS u32x2*)(CP + e0 + (size_t)c * 65536) = o;
        const float so = TCH[(h * 32 + c) * 2], sl = TCH[(h * 32 + c) * 2 + 1];
        C0 = so * C0 + sl * bf_lo(v[c].x); C1 = so * C1 + sl * bf_hi(v[c].x); C2 = so * C2 + sl * bf_lo(v[c].y); C3 = so * C3 + sl * bf_hi(v[c].y); }
}
__device__ __forceinline__ void n_scan(Frame& F) {
    const bf16_t* KWT = (const bf16_t*)(F.ws + WS_KWT); float* NP = (float*)(F.ws + WS_NP); const float* TCH = (const float*)(F.ws + WS_TCH);
    const int gw = (int)blockIdx.x * 8 + F.wave, h = gw >> 8, kd = gw & 255, c = F.lane & 31, half = F.lane >> 5;
    const bf16_t* src = KWT + ((size_t)(h * 32 + c) * 256 + kd) * 256 + 128 * half;
    u32x4 v[16];
#pragma unroll
    for (int i = 0; i < 16; ++i) v[i] = *(const GAS u32x4*)(src + 8 * i);
    const float so = TCH[(h * 32 + c) * 2], sl = TCH[(h * 32 + c) * 2 + 1];
    float s = 0.f;
#pragma unroll
    for (int i = 0; i < 16; ++i) s += ((bf_lo(v[i].x) + bf_hi(v[i].x)) + (bf_lo(v[i].y) + bf_hi(v[i].y))) + ((bf_lo(v[i].z) + bf_hi(v[i].z)) + (bf_lo(v[i].w) + bf_hi(v[i].w)));
    s += __shfl_xor(s, 32);
    float n = 0.f, mine = 0.f;
#pragma unroll
    for (int cc = 0; cc < 32; ++cc) { if (c == cc) mine = n; n = __shfl(so, cc) * n + __shfl(sl, cc) * __shfl(s, cc); }
    if (F.lane < 32) NP[(size_t)(h * 32 + c) * 256 + kd] = mine;
}
__device__ __forceinline__ void rg_carry(Frame& F) {
    const int g = (int)blockIdx.x * 512 + F.tid; if (g >= DM) return;
    const float* AGGA = (const float*)(F.ws + WS_AGGA); const float* AGGB = (const float*)(F.ws + WS_AGGB); float* CARRY = (float*)(F.ws + WS_CARRY);
    float hh = 0.f;
#pragma unroll 8
    for (int pm = 0; pm < 32; ++pm) { CARRY[(size_t)pm * DM + g] = hh; hh = AGGA[(size_t)pm * DM + g] * hh + AGGB[(size_t)pm * DM + g]; }
}

struct Args { float* out; unsigned char* ws; int ph_lo, ph_hi; int flags, pad; Ptrs p; };


__global__ void __launch_bounds__(512, 2) mega_fwd(Args args) {
    __shared__ __attribute__((aligned(16))) unsigned char lds_raw[LDS_BYTES];
    Frame F;
    F.lds = (LAS unsigned char*)lds_raw;
    F.tid = threadIdx.x; F.lane = F.tid & 63; F.wave = __builtin_amdgcn_readfirstlane(F.tid >> 6);
    F.G = gridDim.x; { const int bx = blockIdx.x; F.vcu = (F.G % 8 == 0) ? (bx % 8) * (F.G / 8) + bx / 8 : bx; }
    F.ws = args.ws; F.H = args.out;
    const Ptrs& P = args.p;
    if (args.flags) { const float c = 100.0f * (float)args.flags; for (size_t i = (size_t)blockIdx.x * 512 + threadIdx.x; i < (size_t)SEQ * DM; i += (size_t)gridDim.x * 512) args.out[i] = c; return; }
    volatile LAS unsigned* lctl = (volatile LAS unsigned*)(F.lds + LDS_CTL);
    if (F.tid < 64) lctl[F.tid] = 0u;
    __syncthreads();
    XcdBarrier bar; bar.bar = (unsigned*)(F.ws + WS_CTL); bar.x = 0; bar.st = lctl + 8;
    bar = xcd_barrier_post((unsigned*)(F.ws + WS_CTL), lctl + 8);
    const int lo = args.ph_lo, hi = args.ph_hi;
#ifndef ONLY_PHASE
#define ONLY_PHASE -1
#endif
#define IN(k) ((ONLY_PHASE < 0 || ONLY_PHASE == (k)) && lo <= (k) && (k) < hi)
#ifndef REP_MASK
#define REP_MASK 0
#endif
#ifndef TS_A
#define TS_A -1
#define TS_B -1
#define TS_TA 600.0f
#define TS_TB 800.0f
#endif
    unsigned long long* TS = (unsigned long long*)(F.ws + WS_CTL + 32768);
    if (TS_A >= 0 && blockIdx.x == 0 && threadIdx.x == 0) TS[0] = __builtin_amdgcn_s_memrealtime();
#define PHASE_BEGIN() do { int t_ = threadIdx.x; asm volatile("" : "+v"(t_)); F.tid = t_; F.lane = t_ & 63; } while (0)
#define SEAM(k) do { if (lo <= (k) && (k) + 1 < hi) xcd_barrier(bar); if (TS_A >= 0 && blockIdx.x == 0 && threadIdx.x == 0) TS[(k) + 1] = __builtin_amdgcn_s_memrealtime(); } while (0)

    for (int rep_ = 0; rep_ <= ((REP_MASK >> 0) & 1); ++rep_) if (IN(0)) { PHASE_BEGIN(); convert_weights(F, P, 0, F.vcu * 8 + F.wave, F.G * 8); p0_wif(F, P.in[6], P.in[5]); p0_rows(F, P.in[0]); }
    SEAM(0);
    for (int rep_ = 0; rep_ <= ((REP_MASK >> 1) & 1); ++rep_) if (IN(1)) { PHASE_BEGIN();
        SchedGrid S; S.go.init(SEQ / 256, FF / 128, F.G, (int)blockIdx.x); S.A = (const char*)(F.ws + WS_XB); S.B = (const char*)(F.ws + WS_W1GU); S.a_tile = (size_t)256 * DM * 2; S.b_tile = (size_t)256 * DM * 2;
        EpiSwiglu E{(bf16_t*)(F.ws + WS_HID1), (const float*)(F.ws + WS_SSQ)};
        pg8::gemm_phase<EpiSwiglu, SchedGrid, true>(F.lds, DM * 2, DM * 2, pg8::kseg_plain(DM), S, E);
        if ((int)blockIdx.x >= 128 && rep_ == 0) convert_weights(F, P, 2, ((int)blockIdx.x - 128) * 8 + F.wave, 128 * 8);
    }
    SEAM(1);
    for (int rep_ = 0; rep_ <= ((REP_MASK >> 2) & 1); ++rep_) if (IN(2)) { PHASE_BEGIN();
        SchedGrid S; S.go.init(SEQ / 256, DM / 256, F.G, (int)blockIdx.x); S.A = (const char*)(F.ws + WS_HID1); S.B = (const char*)(F.ws + WS_W1D); S.a_tile = (size_t)256 * FF * 2; S.b_tile = (size_t)256 * FF * 2;
        EpiResid E{P.in[0], F.H, (bf16_t*)(F.ws + WS_XB), (float*)(F.ws + WS_SSQ), 0.5f};
        pg8::gemm_phase<EpiResid, SchedGrid, false>(F.lds, FF * 2, FF * 2, pg8::kseg_plain(FF), S, E);
    }
    SEAM(2);
    for (int rep_ = 0; rep_ <= ((REP_MASK >> 3) & 1); ++rep_) if (IN(3)) { PHASE_BEGIN();
        SchedGrid S; S.go.init(SEQ / 256, 12288 / 256, F.G, (int)blockIdx.x); S.A = (const char*)(F.ws + WS_XB); S.B = (const char*)(F.ws + WS_WIN); S.a_tile = (size_t)256 * DM * 2; S.b_tile = (size_t)256 * DM * 2;
        EpiProj E{(bf16_t*)(F.ws + WS_PROJ), (const float*)(F.ws + WS_SSQ)};
        pg8::gemm_phase<EpiProj, SchedGrid, true>(F.lds, DM * 2, DM * 2, pg8::kseg_plain(DM), S, E);
        thin_gates(F, P.in[19], P.in[20]);
    }
    SEAM(3);
    for (int rep_ = 0; rep_ <= ((REP_MASK >> 4) & 1); ++rep_) if (IN(4)) { PHASE_BEGIN();
        gate_prep(F, (int)blockIdx.x & 7, (int)blockIdx.x >> 3);
        conv_block(F, P, (int)blockIdx.x);
    }
    SEAM(4);
    if (TS_A >= 0 && blockIdx.x == 0 && threadIdx.x == 0) TS[6] = __builtin_amdgcn_s_memrealtime();
    for (int rep_ = 0; rep_ <= ((REP_MASK >> 6) & 1); ++rep_) if (IN(6)) { PHASE_BEGIN();
        const int b = (int)blockIdx.x;
#ifndef SUB
#define SUB 0
#endif
        if (SUB == 0 || SUB == 1) { SchedHC2 S; S.b = b; S.A0 = S.A1 = (const char*)(F.ws + WS_XCM); S.B0 = (const char*)(F.ws + WS_WQ); S.B1 = (const char*)(F.ws + WS_WK);
          S.a_hc_c = (size_t)256 * DM * 2; S.a_hc_h = 512; S.b_hc_c = 0; S.b_hc_h = 131072;
          EpiQK E{(bf16_t*)(F.ws + WS_Q), (bf16_t*)(F.ws + WS_K), (bf16_t*)(F.ws + WS_QS), (const float*)(F.ws + WS_TIW)};
          pg8::gemm_phase<EpiQK, SchedHC2, true>(F.lds, DM * 2, 512, pg8::kseg_plain(256), S, E); }
        if (SUB == 0 || SUB == 2) { SchedHC2 S; S.b = b; S.A0 = (const char*)(F.ws + WS_WK); S.A1 = (const char*)(F.ws + WS_WV); S.B0 = (const char*)(F.ws + WS_XCM); S.B1 = (const char*)(F.ws + WS_MX);
          S.a_hc_c = 0; S.a_hc_h = 131072; S.b_hc_c = (size_t)256 * DM * 2; S.b_hc_h = 512;
          EpiKWVT E{(bf16_t*)(F.ws + WS_KWT), (bf16_t*)(F.ws + WS_VT), (const float*)(F.ws + WS_TWK)};
          pg8::gemm_phase<EpiKWVT, SchedHC2, true>(F.lds, 512, DM * 2, pg8::kseg_plain(256), S, E); }
#pragma unroll 1
        for (int r = 0; r < ((SUB == 0 || SUB == 3) ? 2 : 0); ++r) { SchedRG S; S.L = 2 * b + r; S.A = (const char*)(F.ws + WS_XCRG); S.B = (const char*)(F.ws + WS_WRG);
          EpiRG<false> E{(const bf16_t*)(F.ws + WS_XCRG), P.in[10], P.in[12], P.in[13], (float*)(F.ws + WS_AGGA), (float*)(F.ws + WS_AGGB), nullptr, nullptr, nullptr};
          pg8::gemm_phase<EpiRG<false>, SchedRG, false>(F.lds, DM * 2, 512, pg8::kseg_plain(256), S, E); }
    }
    SEAM(6);
    for (int rep_ = 0; rep_ <= ((REP_MASK >> 7) & 1); ++rep_) if (IN(7)) { PHASE_BEGIN();
        const int b = (int)blockIdx.x;
        rg_carry(F);
        if (SUB == 0 || SUB == 1) { SchedHC1 S; S.b = b; S.A = (const char*)(F.ws + WS_VT); S.B = (const char*)(F.ws + WS_KWT); S.a_c = 131072; S.a_h = (size_t)32 * 131072; S.b_c = 131072; S.b_h = (size_t)32 * 131072;
          EpiCloc E{(bf16_t*)(F.ws + WS_CLOC)};
          pg8::gemm_phase<EpiCloc, SchedHC1, false>(F.lds, 512, 512, pg8::kseg_plain(256), S, E); }
        if (SUB == 0 || SUB == 2) { SchedHC1 S; S.b = b; S.A = (const char*)(F.ws + WS_Q); S.B = (const char*)(F.ws + WS_K); S.a_c = (size_t)256 * DM * 2; S.a_h = 512; S.b_c = (size_t)256 * DM * 2; S.b_h = 512;
          EpiS E{(bf16_t*)(F.ws + WS_P), (float*)(F.ws + WS_DENP), (const float*)(F.ws + WS_TROW), (const float*)(F.ws + WS_TCOL)};
          pg8::gemm_phase<EpiS, SchedHC1, false>(F.lds, DM * 2, DM * 2, pg8::kseg_plain(256), S, E); }
    }
    SEAM(7);
    for (int rep_ = 0; rep_ <= ((REP_MASK >> 8) & 1); ++rep_) if (IN(8)) { PHASE_BEGIN();
        const int b = (int)blockIdx.x;
        state_scan(F); n_scan(F);
#pragma unroll 1
        for (int r = 0; r < 2; ++r) { SchedRG S; S.L = 2 * b + r; S.A = (const char*)(F.ws + WS_XCRG); S.B = (const char*)(F.ws + WS_WRG);
          EpiRG<true> E{(const bf16_t*)(F.ws + WS_XCRG), P.in[10], P.in[12], P.in[13], nullptr, nullptr, (const float*)(F.ws + WS_CARRY), (const bf16_t*)(F.ws + WS_RGG), (bf16_t*)(F.ws + WS_YRG)};
          pg8::gemm_phase<EpiRG<true>, SchedRG, false>(F.lds, DM * 2, 512, pg8::kseg_plain(256), S, E); }
    }
    SEAM(8);
    for (int rep_ = 0; rep_ <= ((REP_MASK >> 9) & 1); ++rep_) if (IN(9)) { PHASE_BEGIN();
        const int b = (int)blockIdx.x;
        convert_weights(F, P, 1, F.vcu * 8 + F.wave, F.G * 8);
        __syncthreads();
        { SchedHC1 S; S.b = b; S.A = (const char*)(F.ws + WS_P); S.B = (const char*)(F.ws + WS_VT); S.a_c = 131072; S.a_h = (size_t)32 * 131072; S.b_c = 131072; S.b_h = (size_t)32 * 131072;
          KSeg ks; ks.nt = 8; ks.sh = 2; ks.mask = 3u; ks.segA = (long)WS_QS - (long)WS_P; ks.segB = (long)WS_CP - (long)WS_VT;
          EpiNum E{(const bf16_t*)(F.ws + WS_QS), (const float*)(F.ws + WS_NP), (const float*)(F.ws + WS_DENP), (const float*)(F.ws + WS_TEMT), P.in[21], P.in[22], (const bf16_t*)(F.ws + WS_XCM), (const bf16_t*)(F.ws + WS_MO), (bf16_t*)(F.ws + WS_YM)};
          pg8::gemm_phase<EpiNum, SchedHC1, false>(F.lds, 512, 512, ks, S, E); }
    }
    SEAM(9);
    for (int rep_ = 0; rep_ <= ((REP_MASK >> 10) & 1); ++rep_) if (IN(10)) { PHASE_BEGIN();
        SchedMerge S; S.go.init(SEQ / 256, DM / 256, F.G, (int)blockIdx.x); S.A0 = (const char*)(F.ws + WS_YRG); S.A1 = (const char*)(F.ws + WS_YM); S.B0 = (const char*)(F.ws + WS_WPRG); S.B1 = (const char*)(F.ws + WS_WPM);
        S.a_tile = (size_t)256 * DM * 2; S.b_tile = (size_t)256 * DM * 2;
        EpiMerge E{(const bf16_t*)(F.ws + WS_GRG), (const bf16_t*)(F.ws + WS_GM), (float*)(F.ws + WS_TMRG), (bf16_t*)(F.ws + WS_MERGED)};
        pg8::gemm_phase<EpiMerge, SchedMerge, false>(F.lds, DM * 2, DM * 2, pg8::kseg_plain(DM), S, E);
    }
    SEAM(10);
    for (int rep_ = 0; rep_ <= ((REP_MASK >> 11) & 1); ++rep_) if (IN(11)) { PHASE_BEGIN();
        SchedGrid S; S.go.init(SEQ / 256, DM / 256, F.G, (int)blockIdx.x); S.A = (const char*)(F.ws + WS_MERGED); S.B = (const char*)(F.ws + WS_WOUT); S.a_tile = (size_t)256 * DM * 2; S.b_tile = (size_t)256 * DM * 2;
        EpiResid E{F.H, F.H, (bf16_t*)(F.ws + WS_XB), (float*)(F.ws + WS_SSQ), 1.0f};
        pg8::gemm_phase<EpiResid, SchedGrid, false>(F.lds, DM * 2, DM * 2, pg8::kseg_plain(DM), S, E);
    }
    SEAM(11);
    for (int rep_ = 0; rep_ <= ((REP_MASK >> 12) & 1); ++rep_) if (IN(12)) { PHASE_BEGIN();
        SchedGrid S; S.go.init(SEQ / 256, FF / 128, F.G, (int)blockIdx.x); S.A = (const char*)(F.ws + WS_XB); S.B = (const char*)(F.ws + WS_W2GU); S.a_tile = (size_t)256 * DM * 2; S.b_tile = (size_t)256 * DM * 2;
        EpiSwiglu E{(bf16_t*)(F.ws + WS_HID2), (const float*)(F.ws + WS_SSQ)};
        pg8::gemm_phase<EpiSwiglu, SchedGrid, true>(F.lds, DM * 2, DM * 2, pg8::kseg_plain(DM), S, E);
    }
    SEAM(12);
    for (int rep_ = 0; rep_ <= ((REP_MASK >> 13) & 1); ++rep_) if (IN(13)) { PHASE_BEGIN();
        SchedGrid S; S.go.init(SEQ / 256, DM / 256, F.G, (int)blockIdx.x); S.A = (const char*)(F.ws + WS_HID2); S.B = (const char*)(F.ws + WS_W2D); S.a_tile = (size_t)256 * FF * 2; S.b_tile = (size_t)256 * FF * 2;
        EpiResid E{F.H, F.H, nullptr, (float*)(F.ws + WS_SSQ), 0.5f};
        pg8::gemm_phase<EpiResid, SchedGrid, false>(F.lds, FF * 2, FF * 2, pg8::kseg_plain(FF), S, E);
    }
    SEAM(13);
    for (int rep_ = 0; rep_ <= ((REP_MASK >> 14) & 1); ++rep_) if (IN(14)) { PHASE_BEGIN(); float dA = 0.f, dB = 0.f;
        if (TS_A >= 0) { dA = (float)(TS[TS_A + 1] - TS[TS_A]) * 0.01f / TS_TA; dB = (float)(TS[TS_B + 1] - TS[TS_B]) * 0.01f / TS_TB; }
        final_norm(F, P.in[30], dA, dB); }
#undef IN
#undef SEAM
}

extern "C" void kernel_launch(void* const* d_in, const int* in_sizes, int n_in, void* d_out, int out_size, void* d_ws, size_t ws_size, hipStream_t stream) {
    int flags = 0;
    if (n_in != 31 || out_size != SEQ * DM) flags |= 1;
    if (ws_size < WS_END) flags |= 2;
    { int per_cu = 0; if (hipOccupancyMaxActiveBlocksPerMultiprocessor(&per_cu, (const void*)mega_fwd, 512, 0) != hipSuccess || per_cu < 1) { flags |= 4; (void)hipGetLastError(); } }
    { int dev = 0, cus = 0; if (hipGetDevice(&dev) != hipSuccess || hipDeviceGetAttribute(&cus, hipDeviceAttributeMultiprocessorCount, dev) != hipSuccess || cus != 256) { flags |= 8; (void)hipGetLastError(); } }
    const int grid = 256;
    (void)hipMemsetAsync((char*)d_ws + WS_CTL, 0, CTL_BYTES, stream);
    Args a{};
    for (int i = 0; i < 31; ++i) a.p.in[i] = (const float*)d_in[i];
    a.out = (float*)d_out; a.ws = (unsigned char*)d_ws; a.ph_lo = 0; a.ph_hi = 100; a.flags = flags;
    hipLaunchKernelGGL(mega_fwd, dim3(grid), dim3(512), 0, stream, a);
}
```
